# Optimizing an MI355X kernel written in HIP

```python
import jax, jax.numpy as jnp
from jax import lax
import numpy as np

D_MODEL = 1024
BATCH = 4
SEQ = 4096
DEPTH = 4

N_MIXERS = 3
N_FOX = (DEPTH + 2) // 3
N_MOBA = (DEPTH + 1) // 3
N_RET = DEPTH // 3

FOX_HEADS = 8
FOX_HD = D_MODEL // FOX_HEADS
FOX_QBLOCK = 128
FOX_IN = 3 * D_MODEL + FOX_HEADS

MOBA_HEADS = 8
MOBA_HD = D_MODEL // MOBA_HEADS
MOBA_BLOCK = 256
MOBA_TOPK = 3
MOBA_QCHUNK = 16
MOBA_IN = 3 * D_MODEL

RET_HEADS = 4
RET_DK = D_MODEL // RET_HEADS
RET_DV = 2 * RET_DK
RET_QK = RET_HEADS * RET_DK
RET_V = RET_HEADS * RET_DV
RET_IN = 2 * RET_QK + 2 * RET_V
RET_CHUNK = 128
RET_ROPE_BASE = 10000.0
RET_GN_EPS = 1e-6

N_EXPERTS = 32
TOP_K = 4
D_FF = D_MODEL
SWIGLU_LIMIT = 7.0
SWIGLU_ALPHA = 1.702
MOE_BLOCK = 256

LN_EPS = 1e-5
DEEPNORM_ALPHA = (2 * DEPTH) ** 0.25
DEEPNORM_BETA = (8 * DEPTH) ** -0.25

kernel_name = 'fox_moba_retnet_moe_deepnorm_trunk'


def layer_norm(x, g, b):
    xf = x.astype(jnp.float32)
    mu = jnp.mean(xf, axis=-1, keepdims=True)
    var = jnp.mean(jnp.square(xf - mu), axis=-1, keepdims=True)
    return ((xf - mu) * lax.rsqrt(var + LN_EPS) * g + b).astype(x.dtype)


def _heads(t, n_heads, hd):
    B, S, _ = t.shape
    return t.reshape(B, S, n_heads, hd).transpose(0, 2, 1, 3)


def forgetting_attention(x, w_in, b_f, w_out):
    B, S, D = x.shape
    proj = x @ w_in
    q = _heads(proj[..., :D], FOX_HEADS, FOX_HD)
    k = _heads(proj[..., D:2 * D], FOX_HEADS, FOX_HD)
    v = _heads(proj[..., 2 * D:3 * D], FOX_HEADS, FOX_HD)
    log_f = jax.nn.log_sigmoid((proj[..., 3 * D:] + b_f).astype(jnp.float32))
    c = jnp.cumsum(log_f, axis=1).transpose(0, 2, 1)
    nq = S // FOX_QBLOCK
    q_blocks = q.reshape(B, FOX_HEADS, nq, FOX_QBLOCK, FOX_HD).transpose(2, 0, 1, 3, 4)
    c_blocks = c.reshape(B, FOX_HEADS, nq, FOX_QBLOCK).transpose(2, 0, 1, 3)
    k_pos = jnp.arange(S)
    scale = FOX_HD ** -0.5

    def block(args):
        qi, ci, i = args
        s = jnp.einsum('bhqd,bhkd->bhqk', qi, k).astype(jnp.float32) * scale
        s = s + ci[..., None] - c[:, :, None, :]
        q_pos = i * FOX_QBLOCK + jnp.arange(FOX_QBLOCK)
        s = jnp.where(k_pos[None, :] <= q_pos[:, None], s, -jnp.inf)
        p = jax.nn.softmax(s, axis=-1).astype(v.dtype)
        return jnp.einsum('bhqk,bhkd->bhqd', p, v)

    o = lax.map(block, (q_blocks, c_blocks, jnp.arange(nq)))
    o = o.transpose(1, 0, 3, 2, 4).reshape(B, S, D)
    return o @ w_out


def moba_attention(x, w_in, w_out):
    B, S, D = x.shape
    proj = x @ w_in
    q = _heads(proj[..., :D], MOBA_HEADS, MOBA_HD)
    k = _heads(proj[..., D:2 * D], MOBA_HEADS, MOBA_HD)
    v = _heads(proj[..., 2 * D:], MOBA_HEADS, MOBA_HD)
    nb = -(-S // MOBA_BLOCK)
    pad = nb * MOBA_BLOCK - S
    k_blk = jnp.pad(k, ((0, 0), (0, 0), (0, pad), (0, 0))).reshape(B, MOBA_HEADS, nb, MOBA_BLOCK, MOBA_HD)
    v_blk = jnp.pad(v, ((0, 0), (0, 0), (0, pad), (0, 0))).reshape(B, MOBA_HEADS, nb, MOBA_BLOCK, MOBA_HD)
    k_mean = jnp.mean(k_blk.astype(jnp.float32), axis=3)
    topk = min(MOBA_TOPK, nb)
    nqc = S // MOBA_QCHUNK
    q_chunks = q.reshape(B, MOBA_HEADS, nqc, MOBA_QCHUNK, MOBA_HD).transpose(2, 0, 1, 3, 4)
    b_ix = jnp.arange(B)[:, None, None, None]
    h_ix = jnp.arange(MOBA_HEADS)[None, :, None, None]
    blk_ids = jnp.arange(nb)
    scale = MOBA_HD ** -0.5

    def chunk(args):
        qi, i = args
        q_pos = i * MOBA_QCHUNK + jnp.arange(MOBA_QCHUNK)
        own = (i * MOBA_QCHUNK) // MOBA_BLOCK
        gate = jnp.einsum('bhqd,bhnd->bhqn', qi.astype(jnp.float32), k_mean)
        gate = jnp.where(blk_ids < own, gate, -jnp.inf)
        _, sel = lax.top_k(gate, topk)
        valid = jnp.arange(topk) < own
        k_sel = k_blk[b_ix, h_ix, sel]
        v_sel = v_blk[b_ix, h_ix, sel]
        s_sel = jnp.einsum('bhqd,bhqnkd->bhqnk', qi, k_sel).astype(jnp.float32) * scale
        s_sel = jnp.where(valid[:, None], s_sel, -jnp.inf).reshape(B, MOBA_HEADS, MOBA_QCHUNK, topk * MOBA_BLOCK)
        k_own = lax.dynamic_index_in_dim(k_blk, own, axis=2, keepdims=False)
        v_own = lax.dynamic_index_in_dim(v_blk, own, axis=2, keepdims=False)
        s_own = jnp.einsum('bhqd,bhkd->bhqk', qi, k_own).astype(jnp.float32) * scale
        own_pos = own * MOBA_BLOCK + jnp.arange(MOBA_BLOCK)
        s_own = jnp.where(own_pos[None, :] <= q_pos[:, None], s_own, -jnp.inf)
        p = jax.nn.softmax(jnp.concatenate([s_sel, s_own], axis=-1), axis=-1).astype(v.dtype)
        p_sel = p[..., :topk * MOBA_BLOCK].reshape(B, MOBA_HEADS, MOBA_QCHUNK, topk, MOBA_BLOCK)
        p_own = p[..., topk * MOBA_BLOCK:]
        return (jnp.einsum('bhqnk,bhqnkd->bhqd', p_sel, v_sel)
                + jnp.einsum('bhqk,bhkd->bhqd', p_own, v_own))

    o = lax.map(chunk, (q_chunks, jnp.arange(nqc)))
    o = o.transpose(1, 0, 3, 2, 4).reshape(B, S, D)
    return o @ w_out


def _rotate(t, cos, sin):
    t1, t2 = jnp.split(t, 2, axis=-1)
    return jnp.concatenate([t1 * cos - t2 * sin, t1 * sin + t2 * cos], axis=-1)


def retention(x, w_in, gn_g, w_out):
    B, S, _ = x.shape
    proj = x @ w_in
    f32 = jnp.float32
    q = _heads(proj[..., :RET_QK], RET_HEADS, RET_DK).astype(f32)
    k = _heads(proj[..., RET_QK:2 * RET_QK], RET_HEADS, RET_DK).astype(f32) * (RET_DK ** -0.5)
    v = _heads(proj[..., 2 * RET_QK:2 * RET_QK + RET_V], RET_HEADS, RET_DV).astype(f32)
    g = proj[..., 2 * RET_QK + RET_V:]
    pos = jnp.arange(S, dtype=f32)
    inv_freq = jnp.exp(-jnp.log(RET_ROPE_BASE) * jnp.arange(0, RET_DK, 2, dtype=f32) / RET_DK)
    ang = pos[:, None] * inv_freq[None, :]
    cos, sin = jnp.cos(ang), jnp.sin(ang)
    q = _rotate(q, cos, sin)
    k = _rotate(k, cos, sin)
    log_gamma = jnp.log(1.0 - jnp.exp2(-5.0 - jnp.arange(RET_HEADS, dtype=f32)))
    n = jnp.arange(RET_CHUNK, dtype=f32)
    diff = n[:, None] - n[None, :]
    d_mask = jnp.where(diff[None] >= 0, jnp.exp(diff[None] * log_gamma[:, None, None]), 0.0)
    xi = jnp.exp((n[None, :] + 1.0) * log_gamma[:, None])
    zeta = jnp.exp((RET_CHUNK - 1.0 - n[None, :]) * log_gamma[:, None])
    g_chunk = jnp.exp(RET_CHUNK * log_gamma)
    nc = S // RET_CHUNK

    def to_chunks(t):
        return t.reshape(B, RET_HEADS, nc, RET_CHUNK, t.shape[-1]).transpose(2, 0, 1, 3, 4)

    def step(R, inp):
        qc, kc, vc = inp
        s = jnp.einsum('bhnd,bhmd->bhnm', qc, kc) * d_mask[None]
        inner = jnp.einsum('bhnm,bhmv->bhnv', s, vc)
        cross = jnp.einsum('bhnd,bhdv->bhnv', qc, R) * xi[None, :, :, None]
        R = g_chunk[None, :, None, None] * R + jnp.einsum('bhmd,bhmv->bhdv', kc, vc * zeta[None, :, :, None])
        return R, inner + cross

    R0 = jnp.zeros((B, RET_HEADS, RET_DK, RET_DV), f32)
    _, o = lax.scan(step, R0, (to_chunks(q), to_chunks(k), to_chunks(v)))
    o = o.transpose(1, 0, 3, 2, 4).reshape(B, S, RET_HEADS, RET_DV)
    mu = jnp.mean(o, axis=-1, keepdims=True)
    var = jnp.mean(jnp.square(o - mu), axis=-1, keepdims=True)
    o = ((o - mu) * lax.rsqrt(var + RET_GN_EPS)).reshape(B, S, RET_V) * gn_g
    o = (jax.nn.silu(g.astype(f32)) * o).astype(x.dtype)
    return o @ w_out


def clamped_swiglu(h):
    glu, lin = h[..., :D_FF], h[..., D_FF:]
    glu = jnp.minimum(glu, SWIGLU_LIMIT)
    lin = jnp.clip(lin, -SWIGLU_LIMIT, SWIGLU_LIMIT)
    return glu * jax.nn.sigmoid(SWIGLU_ALPHA * glu) * (lin + 1.0)


def moe(x2, router_w, router_b, w1, b1, w2, b2):
    T, D = x2.shape
    logits = (x2 @ router_w + router_b).astype(jnp.float32)
    top_v, top_i = lax.top_k(logits, TOP_K)
    gates = jax.nn.softmax(top_v, axis=-1).astype(x2.dtype)
    A = T * TOP_K
    e_flat = top_i.reshape(-1)
    tok_flat = jnp.arange(A, dtype=jnp.int32) // TOP_K
    g_flat = gates.reshape(-1)
    order = jnp.argsort(e_flat)
    e_s, tok_s, g_s = e_flat[order], tok_flat[order], g_flat[order]
    counts = jnp.bincount(e_flat, length=N_EXPERTS)
    starts = jnp.cumsum(counts) - counts
    padded = ((counts + MOE_BLOCK - 1) // MOE_BLOCK) * MOE_BLOCK
    pad_ends = jnp.cumsum(padded)
    pad_starts = pad_ends - padded
    dest = pad_starts[e_s] + (jnp.arange(A, dtype=jnp.int32) - starts[e_s])
    n_blocks = -(-A // MOE_BLOCK) + N_EXPERTS
    P = n_blocks * MOE_BLOCK
    buf_tok = jnp.full((P,), T, jnp.int32).at[dest].set(tok_s)
    buf_g = jnp.zeros((P,), x2.dtype).at[dest].set(g_s)
    blk_start = jnp.arange(n_blocks, dtype=jnp.int32) * MOE_BLOCK
    blk_e = jnp.minimum(jnp.searchsorted(pad_ends, blk_start, side='right'), N_EXPERTS - 1)
    x_pad = jnp.concatenate([x2, jnp.zeros((1, D), x2.dtype)], axis=0)

    def expert_block(args):
        tok, g, e = args
        h = x_pad[tok] @ w1[e] + b1[e]
        y = clamped_swiglu(h) @ w2[e] + b2[e]
        return y * g[:, None]

    y = lax.map(expert_block, (buf_tok.reshape(n_blocks, MOE_BLOCK),
                               buf_g.reshape(n_blocks, MOE_BLOCK), blk_e))
    out = jnp.zeros((T + 1, D), x2.dtype).at[buf_tok].add(y.reshape(P, D))
    return out[:T]


def setup_inputs(seed: int = 0) -> dict:
    key = jax.random.key(seed)
    ks = jax.random.split(key, 20)
    nrm = lambda k, shape: jax.random.normal(k, shape, jnp.float32)
    D = D_MODEL
    x = nrm(ks[0], (BATCH, SEQ, D))
    fox_w_in = nrm(ks[1], (N_FOX, D, FOX_IN)) * D ** -0.5
    fox_b_f = 2.0 + 0.5 * nrm(ks[2], (N_FOX, FOX_HEADS))
    fox_w_out = nrm(ks[3], (N_FOX, D, D)) * (D ** -0.5 * DEEPNORM_BETA)
    moba_w_in = nrm(ks[4], (N_MOBA, D, MOBA_IN)) * D ** -0.5
    moba_w_out = nrm(ks[5], (N_MOBA, D, D)) * (D ** -0.5 * DEEPNORM_BETA)
    ret_w_in = nrm(ks[6], (N_RET, D, RET_IN)) * D ** -0.5
    ret_gn_g = 1.0 + 0.02 * nrm(ks[7], (N_RET, RET_V))
    ret_w_out = nrm(ks[8], (N_RET, RET_V, D)) * (RET_V ** -0.5 * DEEPNORM_BETA)
    ln_g = 1.0 + 0.02 * nrm(ks[9], (DEPTH, 2, D))
    ln_b = 0.02 * nrm(ks[10], (DEPTH, 2, D))
    router_w = nrm(ks[11], (DEPTH, D, N_EXPERTS)) * D ** -0.5
    router_b = 0.01 * nrm(ks[12], (DEPTH, N_EXPERTS))
    moe_w1 = nrm(ks[13], (DEPTH, N_EXPERTS, D, 2 * D_FF)) * D ** -0.5
    moe_b1 = 0.01 * nrm(ks[14], (DEPTH, N_EXPERTS, 2 * D_FF))
    moe_w2 = nrm(ks[15], (DEPTH, N_EXPERTS, D_FF, D)) * (D_FF ** -0.5 * DEEPNORM_BETA)
    moe_b2 = 0.01 * nrm(ks[16], (DEPTH, N_EXPERTS, D))
    return {'x': x, 'fox_w_in': fox_w_in, 'fox_b_f': fox_b_f, 'fox_w_out': fox_w_out,
            'moba_w_in': moba_w_in, 'moba_w_out': moba_w_out,
            'ret_w_in': ret_w_in, 'ret_gn_g': ret_gn_g, 'ret_w_out': ret_w_out,
            'ln_g': ln_g, 'ln_b': ln_b, 'router_w': router_w, 'router_b': router_b,
            'moe_w1': moe_w1, 'moe_b1': moe_b1, 'moe_w2': moe_w2, 'moe_b2': moe_b2}


def reference(x, fox_w_in, fox_b_f, fox_w_out, moba_w_in, moba_w_out, ret_w_in, ret_gn_g,
              ret_w_out, ln_g, ln_b, router_w, router_b, moe_w1, moe_b1, moe_w2, moe_b2):
    B, S, D = x.shape
    for i in range(DEPTH):
        kind = i % N_MIXERS
        j = i // N_MIXERS
        if kind == 0:
            h = forgetting_attention(x, fox_w_in[j], fox_b_f[j], fox_w_out[j])
        elif kind == 1:
            h = moba_attention(x, moba_w_in[j], moba_w_out[j])
        else:
            h = retention(x, ret_w_in[j], ret_gn_g[j], ret_w_out[j])
        x = layer_norm(DEEPNORM_ALPHA * x + h, ln_g[i, 0], ln_b[i, 0])
        y = moe(x.reshape(B * S, D), router_w[i], router_b[i], moe_w1[i], moe_b1[i],
                moe_w2[i], moe_b2[i]).reshape(B, S, D)
        x = layer_norm(DEEPNORM_ALPHA * x + y, ln_g[i, 1], ln_b[i, 1])
    return x
```

```cpp
#include <hip/hip_runtime.h>
#include <cstdio>
#include <cstdint>

#define GAS __attribute__((address_space(1)))
#define LAS __attribute__((address_space(3)))
typedef unsigned short bf16_t;
typedef short bf16x8 __attribute__((ext_vector_type(8)));
typedef short s16x4 __attribute__((ext_vector_type(4)));
typedef float f32x2 __attribute__((ext_vector_type(2)));
typedef float f32x4 __attribute__((ext_vector_type(4)));
typedef float f32x16 __attribute__((ext_vector_type(16)));
typedef unsigned u32x2 __attribute__((ext_vector_type(2)));
typedef unsigned u32x4 __attribute__((ext_vector_type(4)));

constexpr int NB = 4, SEQ = 4096, DM = 1024, T = NB * SEQ;
constexpr int NE = 32, ECAP = T;
constexpr float DN_ALPHA = 1.6817928305074290f;
constexpr float LN_EPS = 1e-5f;
constexpr int NWAVES = 8, NTHREADS = 512;

constexpr size_t MiB = 1ull << 20;
constexpr size_t WS_CTL = 0, CTL_BYTES = 4 * MiB;
constexpr size_t WS_WFOXI = 4 * MiB;
constexpr size_t WS_WFOXO = 16 * MiB;
constexpr size_t WS_WMOBI = 20 * MiB;
constexpr size_t WS_WMOBO = 26 * MiB;
constexpr size_t WS_WRETI = 28 * MiB;
constexpr size_t WS_WRETO = 40 * MiB;
constexpr size_t WS_TAB = 44 * MiB;
constexpr size_t WS_MISC = 52 * MiB;
constexpr size_t WS_W1T = 56 * MiB;
constexpr size_t WS_W2T = 568 * MiB;
constexpr size_t WS_X = 824 * MiB;
constexpr size_t WS_XB = 888 * MiB;
constexpr size_t WS_H = 920 * MiB;
constexpr size_t WS_Q = 984 * MiB;
constexpr size_t WS_K = 1016 * MiB;
constexpr size_t WS_V = 1048 * MiB;
constexpr size_t WS_OA = 1080 * MiB;
constexpr size_t WS_KT = 1112 * MiB;
constexpr size_t WS_VT = 1144 * MiB;
constexpr size_t WS_SG = 1208 * MiB;
constexpr size_t WS_SP = 1272 * MiB;
constexpr size_t WS_UT = 1304 * MiB;
constexpr size_t WS_RT = 1432 * MiB;
constexpr size_t WS_O32 = 1496 * MiB;
constexpr size_t WS_Y = 1624 * MiB;
constexpr size_t WS_XS = 1688 * MiB;
constexpr size_t WS_ACT = 2712 * MiB;
constexpr size_t WS_END = 3736 * MiB;
constexpr size_t MS_LOGF = 0, MS_KMEAN = 512 * 1024, MS_TOKE = 768 * 1024, MS_TOKP = 1024 * 1024, MS_TOKG = 1280 * 1024;
constexpr int CW_BAR = 4096, CW_CNT = 16384;

constexpr int RING_BYTES = 131072, MISC_OFF = RING_BYTES, LDS_BYTES = 147456;
constexpr int LM_BAR = 0, LM_TSTART = 64, LM_CNT = 256, LM_BASE = 384, LM_TE = 512, LM_TLP = 1536, LM_TG = 2560, LM_SCAN = 4096, LM_SEL = 4352, LM_UNI = 5376;

#define LDS_WAIT() asm volatile("s_waitcnt lgkmcnt(0)" ::: "memory")
#define VM_WAIT() asm volatile("s_waitcnt vmcnt(0)" ::: "memory")
__device__ __forceinline__ unsigned cvt_pk_bf16(float lo, float hi) { unsigned r; asm volatile("v_cvt_pk_bf16_f32 %0, %1, %2" : "=v"(r) : "v"(lo), "v"(hi)); return r; }
__device__ __forceinline__ float bf2f(unsigned short b) { return __uint_as_float(((unsigned)b) << 16); }
__device__ __forceinline__ float bflo(unsigned w) { return __uint_as_float(w << 16); }
__device__ __forceinline__ float bfhi(unsigned w) { return __uint_as_float(w & 0xffff0000u); }
__device__ __forceinline__ float wave_sum(float v) {
#pragma unroll
    for (int o = 1; o < 64; o <<= 1) v += __shfl_xor(v, o);
    return v;
}
__device__ __forceinline__ float wave_max(float v) {
#pragma unroll
    for (int o = 1; o < 64; o <<= 1) v = fmaxf(v, __shfl_xor(v, o));
    return v;
}
__device__ __forceinline__ float gamma_log2(int h) { return __builtin_log2f(1.0f - __builtin_exp2f(-5.0f - (float)h)); }

#define XB_TMO      128
#define XB_XCNT(j)  (256  + 64 * (j))
#define XB_XSUB(j)  (1280 + 64 * (j))
#define XB_XGEN(j)  (2304 + 64 * (j))
#define XB_TOP      3328
#define XB_TOPGEN   3392
#define XCD_BAR_WORDS 3456
#define XB_SPIN_CAP (1u << 18)
__device__ __forceinline__ unsigned xb_ld(unsigned* p)              { return __hip_atomic_load(p, __ATOMIC_RELAXED, __HIP_MEMORY_SCOPE_AGENT); }
__device__ __forceinline__ unsigned xb_add(unsigned* p, unsigned v) { return __hip_atomic_fetch_add(p, v, __ATOMIC_RELAXED, __HIP_MEMORY_SCOPE_AGENT); }
__device__ __forceinline__ unsigned xb_xcc_id() { return (unsigned)__builtin_amdgcn_s_getreg((3 << 11) | 20) & 0xFu; }
#define XB_SPIN(cond, bar) do { unsigned _sp = 0; while (cond) { __builtin_amdgcn_s_sleep(1); \
    if ((++_sp & 255u) == 0u) { if (xb_ld(&(bar)[XB_TMO])) break; if (_sp > XB_SPIN_CAP) { atomicAdd(&(bar)[XB_TMO], 1u); break; } } } } while (0)
struct XcdBarrier { unsigned* bar; unsigned x; volatile LAS unsigned* st; };
__device__ __forceinline__ XcdBarrier xcd_barrier_post(unsigned* bar, volatile LAS unsigned* st) {
    XcdBarrier b; b.bar = bar; b.x = xb_xcc_id(); b.st = st;
    if (threadIdx.x == 0) (void)xb_add(&bar[XB_XCNT(b.x)], 1u);
    return b;
}
__device__ __forceinline__ void xcd_barrier_complete(unsigned* bar, unsigned x, unsigned& nloc, unsigned& nx) {
    const unsigned G = gridDim.x * gridDim.y * gridDim.z;
    unsigned sum, cnt, mine, sp = 0u;
    for (;;) {
        sum = 0u; cnt = 0u; mine = 0u;
#pragma unroll
        for (unsigned j = 0; j < 16; ++j) { const unsigned c = xb_ld(&bar[XB_XCNT(j)]); sum += c; cnt += (c > 0u) ? 1u : 0u; mine = (j == x) ? c : mine; }
        if (sum == G) break;
        __builtin_amdgcn_s_sleep(1);
        if ((++sp & 255u) == 0u) { if (xb_ld(&bar[XB_TMO])) break; if (sp > XB_SPIN_CAP) { atomicAdd(&bar[XB_TMO], 1u); break; } }
    }
    nloc = mine > 0u ? mine : 1u; nx = cnt > 0u ? cnt : 1u;
}
__device__ __forceinline__ void xcd_barrier(const XcdBarrier& b) {
    asm volatile("s_waitcnt vmcnt(0)" ::: "memory");
    __syncthreads();
    if (threadIdx.x == 0) {
        unsigned* bar = b.bar;
        __builtin_amdgcn_s_waitcnt(0);
        unsigned nloc = b.st[0], nx = b.st[1];
        if (nloc == 0u) { xcd_barrier_complete(bar, b.x, nloc, nx); b.st[0] = nloc; b.st[1] = nx; }
        const unsigned old = xb_add(&bar[XB_XSUB(b.x)], 1u);
        const unsigned gen = old / nloc;
        if (old + 1u == (gen + 1u) * nloc) {
            __builtin_amdgcn_fence(__ATOMIC_RELEASE, "agent");
            asm volatile("s_waitcnt vmcnt(0)" ::: "memory");
            const unsigned og = xb_add(&bar[XB_TOP], 1u);
            const unsigned tg = og / nx;
            if (og + 1u == (tg + 1u) * nx) xb_add(&bar[XB_TOPGEN], 1u);
            else XB_SPIN(xb_ld(&bar[XB_TOPGEN]) == tg, bar);
            __builtin_amdgcn_fence(__ATOMIC_ACQUIRE, "agent");
            xb_add(&bar[XB_XGEN(b.x)], 1u);
            asm volatile("s_waitcnt vmcnt(0)" ::: "memory");
        } else {
            XB_SPIN(xb_ld(&bar[XB_XGEN(b.x)]) == gen, bar);
            __builtin_amdgcn_fence(__ATOMIC_ACQUIRE, "agent");
            asm volatile("s_waitcnt vmcnt(0)" ::: "memory");
        }
    }
    __syncthreads();
}

namespace pg8 {
constexpr int BM = 256, BK = 64, HALF = 128, HTB = HALF * BK * 2, STAGE_BYTES = 8 * HTB;
__device__ __forceinline__ int lds_byte(int r, int c) { const int st = (r >> 4) * 2 + (c >> 5), rr = r & 15, cc = c & 31, ob = rr * 64 + cc * 2; return st * 1024 + (ob ^ (((ob >> 9) & 1) << 5)); }
__device__ __forceinline__ void stage_rc(int b, int& R, int& C) { const int st = b / 1024, sb = b % 1024, swz = sb ^ (((sb >> 9) & 1) << 5); R = (st >> 1) * 16 + swz / 64; C = (st & 1) * 32 + (swz % 64) / 2; }
__device__ __forceinline__ int perm32(int rho) { const int n = rho >> 4, i = rho & 15; return 8 * (i >> 2) + 4 * n + (i & 3); }
struct Item { const char* A; const char* B; int pm, pn, aux; bool first, last; };

template <class Epi, class Sched>
__device__ __forceinline__ void gemm_phase(LAS unsigned char* lds, const int K, const unsigned pitchA, const unsigned pitchB, const Sched& S, const Epi& E) {
    int tid = threadIdx.x; asm volatile("" : "+v"(tid));
    const int wid = __builtin_amdgcn_readfirstlane(tid >> 6), lane = tid & 63, wr = wid >> 2, wc = wid & 3, fr = lane & 15, fq = lane >> 4;
    const int nt = K / BK;
    unsigned voffA[2], voffB[2];
#pragma unroll
    for (int i = 0; i < 2; ++i) { int R, C; stage_rc(tid * 16 + i * 8192, R, C); const int Rb = Epi::PERM ? ((R & ~31) + perm32(R & 31)) : R;
        voffA[i] = (unsigned)(R * pitchA + C) * 2u; voffB[i] = (unsigned)(Rb * pitchB + C) * 2u; }
    const size_t kstep = (size_t)(BK * 2);
    const size_t hstepA = (size_t)HALF * pitchA * 2, hstepB = (size_t)HALF * pitchB * 2;
    const unsigned ldsw = (unsigned)wid * 1024u;
    const int aoff = lds_byte(wr * 64 + fr, fq * 8), boff = lds_byte(wc * 32 + fr, fq * 8);
#define PG8_SA(b, h) (((b) * 2 + (h)) * HTB)
#define PG8_SB(b, h) ((4 + (b) * 2 + (h)) * HTB)
#define PG8_STAGE(bufoff, gbase, voff) do { _Pragma("unroll") for (int _i = 0; _i < 2; ++_i) \
        __builtin_amdgcn_global_load_lds((const unsigned*)((const char*)(gbase) + (voff)[_i]), (LAS unsigned*)(lds + (bufoff) + ldsw + _i * 8192), 16, 0, 0); } while (0)
#define PG8_LDA(dst, b, h) do { _Pragma("unroll") for (int m = 0; m < 4; ++m) _Pragma("unroll") for (int k = 0; k < 2; ++k) dst[m][k] = *(const LAS bf16x8*)(lds + PG8_SA(b, h) + aoff + m * 2048 + k * 1024); } while (0)
#define PG8_LDB(dst, b, h) do { _Pragma("unroll") for (int n = 0; n < 2; ++n) _Pragma("unroll") for (int k = 0; k < 2; ++k) dst[n][k] = *(const LAS bf16x8*)(lds + PG8_SB(b, h) + boff + n * 2048 + k * 1024); } while (0)
#define PG8_MMA(ai, bj, At, Bt) do { __builtin_amdgcn_s_setprio(1); _Pragma("unroll") for (int m = 0; m < 4; ++m) _Pragma("unroll") for (int n = 0; n < 2; ++n) _Pragma("unroll") for (int k = 0; k < 2; ++k) \
        acc[ai][bj][m][n] = __builtin_amdgcn_mfma_f32_16x16x32_bf16(Bt[n][k], At[m][k], acc[ai][bj][m][n], 0, 0, 0); __builtin_amdgcn_s_setprio(0); } while (0)
#define PG8_WAIT_V(n) asm volatile("s_waitcnt vmcnt(" #n ")" ::: "memory")
#define PG8_WAIT_L(n) asm volatile("s_waitcnt lgkmcnt(" #n ")" ::: "memory")
#define PG8_BAR __builtin_amdgcn_s_barrier()
#define PG8_SCHED __builtin_amdgcn_sched_barrier(0)
#define PG8_ZERO() do { _Pragma("unroll") for (int a = 0; a < 2; ++a) _Pragma("unroll") for (int b = 0; b < 2; ++b) _Pragma("unroll") for (int m = 0; m < 4; ++m) _Pragma("unroll") for (int n = 0; n < 2; ++n) acc[a][b][m][n] = (f32x4){0.f, 0.f, 0.f, 0.f}; } while (0)
    Item cur, nxt; int ui = 0;
    if (!S.next(0, cur)) return;
    f32x4 acc[2][2][4][2];
    PG8_ZERO();
    bf16x8 At[4][2], B0[2][2], B1[2][2];
    const char* cA = cur.A; const char* cB = cur.B;
    PG8_STAGE(PG8_SB(0, 0), cB, voffB); PG8_STAGE(PG8_SA(0, 0), cA, voffA); PG8_STAGE(PG8_SB(0, 1), cB + hstepB, voffB); PG8_STAGE(PG8_SA(0, 1), cA + hstepA, voffA);
    if (wr == 1) PG8_BAR;
    PG8_WAIT_V(4); PG8_BAR;
    PG8_STAGE(PG8_SB(1, 0), cB + kstep, voffB); PG8_STAGE(PG8_SA(1, 0), cA + kstep, voffA); PG8_STAGE(PG8_SB(1, 1), cB + hstepB + kstep, voffB);
    PG8_WAIT_V(6); PG8_BAR;
    for (;;) {
        const bool has_next = S.next(ui + 1, nxt);
        const char* nA = has_next ? nxt.A : cA; const char* nB = has_next ? nxt.B : cB;
        for (int t = 0; t < nt; t += 2) {
            const bool last = (t == nt - 2);
            const char* a1 = cA + (size_t)(t + 1) * kstep;
            const char* a2 = last ? nA : cA + (size_t)(t + 2) * kstep; const char* b2 = last ? nB : cB + (size_t)(t + 2) * kstep;
            const char* a3 = a2 + kstep; const char* b3 = b2 + kstep;
            PG8_LDB(B0, 0, 0); PG8_SCHED; PG8_LDA(At, 0, 0); PG8_STAGE(PG8_SA(1, 1), a1 + hstepA, voffA);
            PG8_WAIT_L(8); PG8_BAR; PG8_WAIT_L(0); PG8_MMA(0, 0, At, B0); PG8_BAR; PG8_SCHED;
            PG8_LDB(B1, 0, 1); PG8_STAGE(PG8_SB(0, 0), b2, voffB);
            PG8_BAR; PG8_WAIT_L(0); PG8_MMA(0, 1, At, B1); PG8_BAR;
            PG8_LDA(At, 0, 1); PG8_STAGE(PG8_SA(0, 0), a2, voffA);
            PG8_BAR; PG8_WAIT_L(0); PG8_MMA(1, 0, At, B0); PG8_BAR; PG8_SCHED;
            PG8_STAGE(PG8_SB(0, 1), b2 + hstepB, voffB);
            PG8_WAIT_V(6); PG8_BAR; PG8_MMA(1, 1, At, B1); PG8_BAR;
            PG8_LDB(B0, 1, 0); PG8_SCHED; PG8_LDA(At, 1, 0); PG8_STAGE(PG8_SA(0, 1), a2 + hstepA, voffA);
            PG8_WAIT_L(8); PG8_BAR; PG8_WAIT_L(0); PG8_MMA(0, 0, At, B0); PG8_BAR; PG8_SCHED;
            PG8_LDB(B1, 1, 1); PG8_STAGE(PG8_SB(1, 0), b3, voffB);
            PG8_BAR; PG8_WAIT_L(0); PG8_MMA(0, 1, At, B1); PG8_BAR;
            PG8_LDA(At, 1, 1); PG8_STAGE(PG8_SA(1, 0), a3, voffA);
            PG8_BAR; PG8_WAIT_L(0); PG8_MMA(1, 0, At, B0); PG8_BAR; PG8_SCHED;
            PG8_STAGE(PG8_SB(1, 1), b3 + hstepB, voffB);
            PG8_WAIT_V(6); PG8_BAR; PG8_MMA(1, 1, At, B1); PG8_BAR;
        }
        if (cur.last) { E(acc, cur, wr, wc, fr, fq); }
        if (!has_next) break;
        if (cur.last) { PG8_ZERO(); }
        cur = nxt; cA = nA; cB = nB; ++ui;
    }
    PG8_WAIT_V(0);
    if (wr == 0) PG8_BAR;
    PG8_BAR;
#undef PG8_SA
#undef PG8_SB
#undef PG8_STAGE
#undef PG8_LDA
#undef PG8_LDB
#undef PG8_MMA
#undef PG8_WAIT_V
#undef PG8_WAIT_L
#undef PG8_BAR
#undef PG8_SCHED
#undef PG8_ZERO
}

struct DenseOrder {
    const char* A; const char* B; size_t tA, tB; int nM, nN, nwg, G, c;
    __device__ __forceinline__ void init(const void* A_, const void* B_, int M, int N, unsigned pitchA, unsigned pitchB, int G_, int c_) {
        A = (const char*)A_; B = (const char*)B_; nM = M / BM; nN = N / BM; nwg = nM * nN; G = G_; c = c_; tA = (size_t)BM * pitchA * 2; tB = (size_t)BM * pitchB * 2; }
    __device__ __forceinline__ bool next(int i, Item& it) const {
        const long L = (long)i * G + c; if (L >= nwg) return false;
        int wgid = (int)L; { const int q = nwg / 8, r = nwg % 8, xcd = wgid % 8, off = wgid / 8; wgid = (xcd < r ? xcd * (q + 1) : r * (q + 1) + (xcd - r) * q) + off; }
        const int nig = 8 * nN, gid = wgid / nig, fm = gid * 8, gsz = (nM - fm) < 8 ? (nM - fm) : 8;
        it.pm = fm + ((wgid % nig) % gsz); it.pn = (wgid % nig) / gsz; it.aux = 0; it.first = true; it.last = true;
        it.A = A + (size_t)it.pm * tA; it.B = B + (size_t)it.pn * tB; return true;
    }
};
struct MoeOrder {
    const char* A; const char* B; const LAS int* tstart; size_t eB; int ntiles, npn, G, c; unsigned pitchA;
    __device__ __forceinline__ bool next(int i, Item& it) const {
        const long L = (long)i * G + c; if (L >= (long)ntiles * npn) return false;
        const int tile = (int)(L / npn), pn = (int)(L % npn), lane = threadIdx.x & 63;
        bool mine = false; if (lane < 32) { mine = (tstart[lane] <= tile) && (tile < tstart[lane + 1]); }
        const unsigned long long bal = __ballot(mine);
        const int e = __builtin_amdgcn_readfirstlane((int)__builtin_ctzll(bal | (1ull << 63)));
        const int j = tile - __builtin_amdgcn_readfirstlane(tstart[e]);
        it.pm = e * (ECAP / BM) + j; it.pn = pn; it.aux = e; it.first = true; it.last = true;
        it.A = A + (size_t)it.pm * BM * pitchA * 2; it.B = B + (size_t)e * eB + (size_t)pn * BM * 1024 * 2; return true;
    }
};
struct RetSOrder {
    const char* Q; const char* Kp; int G, c;
    __device__ __forceinline__ bool next(int i, Item& it) const {
        const int L = i * G + c; if (L >= 256) return false;
        it.pm = L >> 2; it.pn = L & 3; it.aux = 0; it.first = true; it.last = true;
        const size_t off = ((size_t)it.pm * 256 * 1024 + (size_t)it.pn * 256) * 2; it.A = Q + off; it.B = Kp + off; return true;
    }
};
struct RetUOrder {
    const char* VT; const char* KT; int G, c;
    __device__ __forceinline__ bool next(int i, Item& it) const {
        const int L = i * G + c; if (L >= 512) return false;
        const int bh = L >> 5, ch = (L >> 1) & 15, vt = L & 1, b = bh >> 2, h = bh & 3;
        it.pm = L; it.pn = 0; it.aux = 0; it.first = true; it.last = true;
        it.A = VT + (((size_t)b * 2048 + h * 512 + vt * 256) * 4096 + (size_t)ch * 256) * 2;
        it.B = KT + (((size_t)b * 1024 + h * 256) * 4096 + (size_t)ch * 256) * 2; return true;
    }
};
struct RetOOrder {
    const char* Q; const char* SP; const char* RT; const char* VT; int G, c;
    __device__ __forceinline__ bool next(int i, Item& it) const {
        const int L = (i >> 1) * G + c; if (L >= 512) return false;
        const int seg = i & 1, bh = L >> 5, ch = (L >> 1) & 15, vt = L & 1, b = bh >> 2, h = bh & 3;
        it.pm = L; it.pn = 0; it.aux = 0; it.first = (seg == 0); it.last = (seg == 1);
        const size_t aoff = (((size_t)b * 4096 + (size_t)ch * 256) * 1024 + (size_t)h * 256) * 2;
        if (seg == 0) { it.A = Q + aoff; it.B = RT + (((size_t)bh * 512 + vt * 256) * 4096 + (size_t)ch * 256) * 2; }
        else { it.A = SP + aoff; it.B = VT + (((size_t)b * 2048 + h * 512 + vt * 256) * 4096 + (size_t)ch * 256) * 2; }
        return true;
    }
};

typedef f32x4 Acc[2][2][4][2];
struct EpiQKV { static constexpr bool PERM = true; bf16_t* O;
    __device__ __forceinline__ void operator()(const Acc& acc, const Item& u, int wr, int wc, int fr, int fq) const {
        asm volatile("" : "+v"(fr), "+v"(fq));
        const int row0 = u.pm * BM + wr * 64 + fr; const int t = u.pn >> 2; bf16_t* base = O + (size_t)t * T * 1024; const int col0 = (u.pn & 3) * 256 + wc * 32 + 8 * fq;
#pragma unroll
        for (int ai = 0; ai < 2; ++ai)
#pragma unroll
            for (int m = 0; m < 4; ++m) { bf16_t* rowp = base + (size_t)(row0 + ai * HALF + m * 16) * 1024 + col0;
#pragma unroll
                for (int bj = 0; bj < 2; ++bj) { const f32x4 v0 = acc[ai][bj][m][0], v1 = acc[ai][bj][m][1];
                    u32x4 w; w.x = cvt_pk_bf16(v0[0], v0[1]); w.y = cvt_pk_bf16(v0[2], v0[3]); w.z = cvt_pk_bf16(v1[0], v1[1]); w.w = cvt_pk_bf16(v1[2], v1[3]);
                    *(u32x4*)(rowp + bj * HALF) = w; } }
    }
};
struct EpiF32 { static constexpr bool PERM = false; float* C; int ldc;
    __device__ __forceinline__ void operator()(const Acc& acc, const Item& u, int wr, int wc, int fr, int fq) const {
        asm volatile("" : "+v"(fr), "+v"(fq));
        const int row0 = u.pm * BM + wr * 64 + fr, col0 = u.pn * BM + wc * 32 + 4 * fq;
#pragma unroll
        for (int ai = 0; ai < 2; ++ai)
#pragma unroll
            for (int m = 0; m < 4; ++m) { float* rowp = C + (size_t)(row0 + ai * HALF + m * 16) * ldc + col0;
#pragma unroll
                for (int bj = 0; bj < 2; ++bj)
#pragma unroll
                    for (int n = 0; n < 2; ++n) *(f32x4*)(rowp + bj * HALF + n * 16) = acc[ai][bj][m][n]; }
    }
};
struct EpiSwiglu { static constexpr bool PERM = true; bf16_t* O; const float* b1;
    __device__ __forceinline__ void operator()(const Acc& acc, const Item& u, int wr, int wc, int fr, int fq) const {
        asm volatile("" : "+v"(fr), "+v"(fq));
        const int row0 = u.pm * BM + wr * 64 + fr, j0 = u.pn * 128 + wc * 32 + 8 * fq;
        const float* bb = b1 + (size_t)u.aux * 2048 + j0;
        f32x4 bg[2], bl[2];
#pragma unroll
        for (int n = 0; n < 2; ++n) { bg[n] = *(const f32x4*)(bb + 4 * n); bl[n] = *(const f32x4*)(bb + 1024 + 4 * n); }
#pragma unroll
        for (int ai = 0; ai < 2; ++ai)
#pragma unroll
            for (int m = 0; m < 4; ++m) { float o[8];
#pragma unroll
                for (int n = 0; n < 2; ++n)
#pragma unroll
                    for (int i = 0; i < 4; ++i) { float g = acc[ai][0][m][n][i] + bg[n][i], l = acc[ai][1][m][n][i] + bl[n][i];
                        g = fminf(g, 7.0f); l = fminf(fmaxf(l, -7.0f), 7.0f);
                        const float sg = __builtin_amdgcn_rcpf(1.0f + __builtin_amdgcn_exp2f(-1.702f * 1.4426950408889634f * g));
                        o[n * 4 + i] = g * sg * (l + 1.0f); }
                u32x4 w; w.x = cvt_pk_bf16(o[0], o[1]); w.y = cvt_pk_bf16(o[2], o[3]); w.z = cvt_pk_bf16(o[4], o[5]); w.w = cvt_pk_bf16(o[6], o[7]);
                *(u32x4*)(O + (size_t)(row0 + ai * HALF + m * 16) * 1024 + j0) = w; }
    }
};
struct EpiY { static constexpr bool PERM = true; bf16_t* O; const float* b2;
    __device__ __forceinline__ void operator()(const Acc& acc, const Item& u, int wr, int wc, int fr, int fq) const {
        asm volatile("" : "+v"(fr), "+v"(fq));
        const int row0 = u.pm * BM + wr * 64 + fr, col0 = u.pn * BM + wc * 32 + 8 * fq;
        const float* bb = b2 + (size_t)u.aux * 1024 + col0;
        f32x4 bv[2][2];
#pragma unroll
        for (int bj = 0; bj < 2; ++bj)
#pragma unroll
            for (int n = 0; n < 2; ++n) bv[bj][n] = *(const f32x4*)(bb + bj * HALF + 4 * n);
#pragma unroll
        for (int ai = 0; ai < 2; ++ai)
#pragma unroll
            for (int m = 0; m < 4; ++m) { bf16_t* rowp = O + (size_t)(row0 + ai * HALF + m * 16) * 1024 + col0;
#pragma unroll
                for (int bj = 0; bj < 2; ++bj) { const f32x4 v0 = acc[ai][bj][m][0] + bv[bj][0], v1 = acc[ai][bj][m][1] + bv[bj][1];
                    u32x4 w; w.x = cvt_pk_bf16(v0[0], v0[1]); w.y = cvt_pk_bf16(v0[2], v0[3]); w.z = cvt_pk_bf16(v1[0], v1[1]); w.w = cvt_pk_bf16(v1[2], v1[3]);
                    *(u32x4*)(rowp + bj * HALF) = w; } }
    }
};
struct EpiRope { static constexpr bool PERM = true; bf16_t* Qp; bf16_t* Kp; const float* cs; const float* sn;
    __device__ __forceinline__ void operator()(const Acc& acc, const Item& u, int wr, int wc, int fr, int fq) const {
        asm volatile("" : "+v"(fr), "+v"(fq));
        const bool isk = u.pn >= 4; const int h = u.pn & 3; bf16_t* dst = (isk ? Kp : Qp) + (size_t)u.pm * BM * 1024 + h * 256;
        const float lg = gamma_log2(h); const int posb = (u.pm & 15) * 256; const int j0 = wc * 32 + 8 * fq;
#pragma unroll
        for (int ai = 0; ai < 2; ++ai)
#pragma unroll
            for (int m = 0; m < 4; ++m) { const int r = ai * HALF + wr * 64 + m * 16 + fr;
                const float f = isk ? __builtin_amdgcn_exp2f(-(float)r * lg) * 0.0625f : __builtin_amdgcn_exp2f((float)r * lg);
                const float* cp = cs + (size_t)(posb + r) * 128 + j0; const float* sp = sn + (size_t)(posb + r) * 128 + j0;
#pragma unroll
                for (int n = 0; n < 2; ++n) { const f32x4 c4 = *(const f32x4*)(cp + 4 * n), s4 = *(const f32x4*)(sp + 4 * n);
                    const f32x4 t1 = acc[ai][0][m][n], t2 = acc[ai][1][m][n];
                    const f32x4 o1 = (t1 * c4 - t2 * s4) * f, o2 = (t1 * s4 + t2 * c4) * f;
                    u32x2 w1, w2; w1.x = cvt_pk_bf16(o1[0], o1[1]); w1.y = cvt_pk_bf16(o1[2], o1[3]); w2.x = cvt_pk_bf16(o2[0], o2[1]); w2.y = cvt_pk_bf16(o2[2], o2[3]);
                    *(u32x2*)(dst + (size_t)r * 1024 + j0 + 4 * n) = w1; *(u32x2*)(dst + (size_t)r * 1024 + 128 + j0 + 4 * n) = w2; }
                asm volatile("" ::: "memory"); }
    }
};
struct EpiSwap { static constexpr bool PERM = true; bf16_t* VT;
    __device__ __forceinline__ void operator()(const Acc& acc, const Item& u, int wr, int wc, int fr, int fq) const {
        asm volatile("" : "+v"(fr), "+v"(fq));
        const int b = u.pn >> 4, ch = u.pn & 15;
        bf16_t* dst = VT + ((size_t)b * 2048 + (size_t)u.pm * 256) * 4096 + (size_t)ch * 256;
#pragma unroll
        for (int ai = 0; ai < 2; ++ai)
#pragma unroll
            for (int m = 0; m < 4; ++m) { bf16_t* rowp = dst + (size_t)(ai * HALF + wr * 64 + m * 16 + fr) * 4096 + wc * 32 + 8 * fq;
#pragma unroll
                for (int bj = 0; bj < 2; ++bj) { const f32x4 v0 = acc[ai][bj][m][0], v1 = acc[ai][bj][m][1];
                    u32x4 w; w.x = cvt_pk_bf16(v0[0], v0[1]); w.y = cvt_pk_bf16(v0[2], v0[3]); w.z = cvt_pk_bf16(v1[0], v1[1]); w.w = cvt_pk_bf16(v1[2], v1[3]);
                    *(u32x4*)(rowp + bj * HALF) = w; } }
    }
};
struct EpiSilu { static constexpr bool PERM = true; bf16_t* O;
    __device__ __forceinline__ void operator()(const Acc& acc, const Item& u, int wr, int wc, int fr, int fq) const {
        asm volatile("" : "+v"(fr), "+v"(fq));
        const int row0 = u.pm * BM + wr * 64 + fr, col0 = u.pn * BM + wc * 32 + 8 * fq;
#pragma unroll
        for (int ai = 0; ai < 2; ++ai)
#pragma unroll
            for (int m = 0; m < 4; ++m) { bf16_t* rowp = O + (size_t)(row0 + ai * HALF + m * 16) * 2048 + col0;
#pragma unroll
                for (int bj = 0; bj < 2; ++bj) { float o[8];
#pragma unroll
                    for (int n = 0; n < 2; ++n)
#pragma unroll
                        for (int i = 0; i < 4; ++i) { const float g = acc[ai][bj][m][n][i]; o[n * 4 + i] = g * __builtin_amdgcn_rcpf(1.0f + __builtin_amdgcn_exp2f(-1.4426950408889634f * g)); }
                    u32x4 w; w.x = cvt_pk_bf16(o[0], o[1]); w.y = cvt_pk_bf16(o[2], o[3]); w.z = cvt_pk_bf16(o[4], o[5]); w.w = cvt_pk_bf16(o[6], o[7]);
                    *(u32x4*)(rowp + bj * HALF) = w; } }
    }
};
struct EpiSMask { static constexpr bool PERM = true; bf16_t* O;
    __device__ __forceinline__ void operator()(const Acc& acc, const Item& u, int wr, int wc, int fr, int fq) const {
        asm volatile("" : "+v"(fr), "+v"(fq));
        bf16_t* dst = O + (size_t)u.pm * BM * 1024 + u.pn * 256;
        int cb = wc * 32 + 8 * fq; asm volatile("" : "+v"(cb));
#pragma unroll
        for (int ai = 0; ai < 2; ++ai)
#pragma unroll
            for (int m = 0; m < 4; ++m) { int r = ai * HALF + wr * 64 + m * 16 + fr; asm volatile("" : "+v"(r) :: "memory");
#pragma unroll
                for (int bj = 0; bj < 2; ++bj) { const int c0 = bj * HALF + cb; float o[8];
#pragma unroll
                    for (int n = 0; n < 2; ++n)
#pragma unroll
                        for (int i = 0; i < 4; ++i) o[n * 4 + i] = acc[ai][bj][m][n][i] * __builtin_amdgcn_fmed3f((float)(r - c0 - n * 4 - i + 1), 0.f, 1.f);
                    u32x4 w; w.x = cvt_pk_bf16(o[0], o[1]); w.y = cvt_pk_bf16(o[2], o[3]); w.z = cvt_pk_bf16(o[4], o[5]); w.w = cvt_pk_bf16(o[6], o[7]);
                    *(u32x4*)(dst + (size_t)r * 1024 + c0) = w; } }
    }
};
struct EpiUT { static constexpr bool PERM = false; float* C;
    __device__ __forceinline__ void operator()(const Acc& acc, const Item& u, int wr, int wc, int fr, int fq) const {
        asm volatile("" : "+v"(fr), "+v"(fq));
        const int row0 = wr * 64 + fr, col0 = wc * 32 + 4 * fq; float* base = C + (size_t)u.pm * 256 * 256;
#pragma unroll
        for (int ai = 0; ai < 2; ++ai)
#pragma unroll
            for (int m = 0; m < 4; ++m) { float* rowp = base + (size_t)(row0 + ai * HALF + m * 16) * 256 + col0;
#pragma unroll
                for (int bj = 0; bj < 2; ++bj)
#pragma unroll
                    for (int n = 0; n < 2; ++n) *(f32x4*)(rowp + bj * HALF + n * 16) = acc[ai][bj][m][n]; }
    }
};
struct EpiRetO { static constexpr bool PERM = false; float* C;
    __device__ __forceinline__ void operator()(const Acc& acc, const Item& u, int wr, int wc, int fr, int fq) const {
        asm volatile("" : "+v"(fr), "+v"(fq));
        const int L = u.pm, bh = L >> 5, ch = (L >> 1) & 15, vt = L & 1, b = bh >> 2, h = bh & 3;
        float* base = C + ((size_t)b * 4096 + (size_t)ch * 256) * 2048 + h * 512 + vt * 256; const int row0 = wr * 64 + fr, col0 = wc * 32 + 4 * fq;
#pragma unroll
        for (int ai = 0; ai < 2; ++ai)
#pragma unroll
            for (int m = 0; m < 4; ++m) { float* rowp = base + (size_t)(row0 + ai * HALF + m * 16) * 2048 + col0;
#pragma unroll
                for (int bj = 0; bj < 2; ++bj)
#pragma unroll
                    for (int n = 0; n < 2; ++n) *(f32x4*)(rowp + bj * HALF + n * 16) = acc[ai][bj][m][n]; }
    }
};
}

namespace att {
constexpr int D = 128, PITCH = 1024, NW = 8, QBLK = 32, KVBLK = 64, QB = 256;
constexpr float SCALE = 0.08838834764831845f;
constexpr float THR = 8.f;
constexpr int SHM_V = KVBLK * D * 2, SHM_K = KVBLK * D * 2;
constexpr int LDS_BYTES = 2 * SHM_V + 2 * SHM_K + NW * 64 * 4;
constexpr int LDS_CS = LDS_BYTES;
#define KSWZ(row, colB) ((row) * 256 + ((colB) ^ (((row) & 7) << 4)))
#define SBAR() __builtin_amdgcn_sched_barrier(0)
__device__ __forceinline__ int v_st(int k, int c) { const int kk = (k & ~0xC) | ((k & 4) << 1) | ((k & 8) >> 1); return ((kk >> 3) * 4 + (c >> 5)) * 512 + ((kk & 7) * 32 + (c & 31)) * 2; }
__device__ __forceinline__ int v_rd_base(int lane) { return ((lane & 3) << 3) | (((lane >> 2) & 3) << 6) | (((lane >> 4) & 1) << 5) | (((lane >> 5) & 1) << 8); }
constexpr int v_rd_off(int d0, int ks, int half) { return d0 * 512 + ks * 4096 + half * 2048; }
__device__ __forceinline__ int crow(int r, int hi) { return (r & 3) + 8 * (r >> 2) + 4 * hi; }
__device__ __forceinline__ unsigned cvtpk(float lo, float hi) { unsigned r; asm volatile("v_cvt_pk_bf16_f32 %0, %1, %2" : "=v"(r) : "v"(lo), "v"(hi)); return r; }
__device__ __forceinline__ void mask_tile(f32x16& p0, f32x16& p1, int dq) {
    const float NEG = -__builtin_inff();
#pragma unroll
    for (int r = 0; r < 16; ++r) { const int c = (r & 3) + 8 * (r >> 2);
        if (dq - c < 0) p0[r] = NEG;
        if (dq - c - 32 < 0) p1[r] = NEG; }
}
__device__ __forceinline__ void partialSM(f32x16& p0, f32x16& p1, float& m_reg, float& alpha, const float cq) {
    float pmax = p0[0];
#pragma unroll
    for (int r = 1; r < 16; ++r) pmax = fmaxf(pmax, p0[r]);
#pragma unroll
    for (int r = 0; r < 16; ++r) pmax = fmaxf(pmax, p1[r]);
    { auto rr = __builtin_amdgcn_permlane32_swap(__float_as_uint(pmax), __float_as_uint(pmax), false, false);
      pmax = fmaxf(__uint_as_float(rr[0]), __uint_as_float(rr[1])); }
    pmax += cq;
    constexpr float C2 = 1.4426950408889634f * SCALE;
    float mn;
    if (__builtin_expect(__all((pmax - m_reg) * SCALE <= THR), 1)) { mn = m_reg; alpha = 1.f; }
    else { mn = fmaxf(m_reg, pmax); alpha = __builtin_amdgcn_exp2f((m_reg - mn) * C2); m_reg = mn; }
    const float mnL = (cq - mn) * C2;
#pragma unroll
    for (int r = 0; r < 16; ++r) p0[r] = fmaf(p0[r], C2, mnL);
#pragma unroll
    for (int r = 0; r < 16; ++r) p1[r] = fmaf(p1[r], C2, mnL);
}
__device__ __forceinline__ void finishSM(f32x16& p0, f32x16& p1, float alpha, float& l_reg, bf16x8& pa0, bf16x8& pa1, bf16x8& pa2, bf16x8& pa3) {
#pragma unroll
    for (int r = 0; r < 16; ++r) p0[r] = __builtin_amdgcn_exp2f(p0[r]);
#pragma unroll
    for (int r = 0; r < 16; ++r) p1[r] = __builtin_amdgcn_exp2f(p1[r]);
    float ps = 0;
#pragma unroll
    for (int r = 0; r < 16; ++r) ps += p0[r];
#pragma unroll
    for (int r = 0; r < 16; ++r) ps += p1[r];
    { auto rr = __builtin_amdgcn_permlane32_swap(__float_as_uint(ps), __float_as_uint(ps), false, false);
      ps = __uint_as_float(rr[0]) + __uint_as_float(rr[1]); }
    l_reg = l_reg * alpha + ps;
#define PK4(P, B_, OUT) do { unsigned a0 = cvtpk(P[B_+0], P[B_+1]), a1 = cvtpk(P[B_+2], P[B_+3]);                          \
        unsigned b0 = cvtpk(P[B_+4], P[B_+5]), b1 = cvtpk(P[B_+6], P[B_+7]);                                             \
        auto r0 = __builtin_amdgcn_permlane32_swap(a0, b0, false, false); auto r1 = __builtin_amdgcn_permlane32_swap(a1, b1, false, false); \
        u32x4 w = {r0[0], r1[0], r0[1], r1[1]}; OUT = *reinterpret_cast<bf16x8*>(&w); } while (0)
    PK4(p0, 0, pa0); PK4(p0, 8, pa1); PK4(p1, 0, pa2); PK4(p1, 8, pa3);
#undef PK4
}
template <int KB, int MODE>
__device__ __forceinline__ void qkt(f32x16& p0, f32x16& p1, const char* K_lds, const float* init, int r32, int hi, const bf16x8* qr) {
    if (MODE == 0) {
#pragma unroll
        for (int g = 0; g < 4; ++g) { const f32x4 a = *(const f32x4*)(init + 8 * g), b = *(const f32x4*)(init + 32 + 8 * g);
#pragma unroll
            for (int i = 0; i < 4; ++i) { p0[4 * g + i] = a[i]; p1[4 * g + i] = b[i]; } }
    } else { p0 = f32x16{}; p1 = f32x16{}; }
    const char* kb[4];
#pragma unroll
    for (int dd = 0; dd < 4; ++dd) kb[dd] = K_lds + KB * SHM_K + KSWZ(r32, (dd * 16 + hi * 8) * 2);
#pragma unroll
    for (int d0 = 0; d0 < 8; ++d0) { const char* a = kb[d0 & 3] + (d0 >> 2) * 128;
        bf16x8 b0 = *reinterpret_cast<const bf16x8*>(a);
        bf16x8 b1 = *reinterpret_cast<const bf16x8*>(a + 32 * 256);
        p0 = __builtin_amdgcn_mfma_f32_32x32x16_bf16(b0, qr[d0], p0, 0, 0, 0);
        p1 = __builtin_amdgcn_mfma_f32_32x32x16_bf16(b1, qr[d0], p1, 0, 0, 0); }
}
template <int VB>
__device__ __forceinline__ void pv_tile(f32x16* o, int vb0, bf16x8 pa0, bf16x8 pa1, bf16x8 pa2, bf16x8 pa3) {
#define TRRD(dst, off) asm volatile("ds_read_b64_tr_b16 %0, %1 offset:%2" : "=&v"(dst) : "v"(vb0), "i"(off) : "memory")
#define PV_D0(d0) do { s16x4 l0, l1, l2, l3, h0, h1, h2, h3; constexpr int b_ = VB * SHM_V + v_rd_off(d0, 0, 0); \
        TRRD(l0, b_); TRRD(h0, b_ + 2048); TRRD(l1, b_ + 4096); TRRD(h1, b_ + 6144); TRRD(l2, b_ + 8192); TRRD(h2, b_ + 10240); TRRD(l3, b_ + 12288); TRRD(h3, b_ + 14336); \
        asm volatile("s_waitcnt lgkmcnt(0)" ::: "memory"); SBAR();   \
        o[d0] = __builtin_amdgcn_mfma_f32_32x32x16_bf16(pa0, (bf16x8){l0[0], l0[1], l0[2], l0[3], h0[0], h0[1], h0[2], h0[3]}, o[d0], 0, 0, 0);   \
        o[d0] = __builtin_amdgcn_mfma_f32_32x32x16_bf16(pa1, (bf16x8){l1[0], l1[1], l1[2], l1[3], h1[0], h1[1], h1[2], h1[3]}, o[d0], 0, 0, 0);   \
        o[d0] = __builtin_amdgcn_mfma_f32_32x32x16_bf16(pa2, (bf16x8){l2[0], l2[1], l2[2], l2[3], h2[0], h2[1], h2[2], h2[3]}, o[d0], 0, 0, 0);   \
        o[d0] = __builtin_amdgcn_mfma_f32_32x32x16_bf16(pa3, (bf16x8){l3[0], l3[1], l3[2], l3[3], h3[0], h3[1], h3[2], h3[3]}, o[d0], 0, 0, 0); } while (0)
    PV_D0(0); PV_D0(1); PV_D0(2); PV_D0(3);
#undef PV_D0
#undef TRRD
}
struct BlockRef { const bf16_t* Q; const bf16_t* K; const bf16_t* V; bf16_t* O; int P0; };
#define ROW(p, k0, rr) ((p) + (size_t)((k0) + (rr)) * PITCH + sc)
#define VMW() asm volatile("s_waitcnt vmcnt(0)" ::: "memory")
#define LD8(p) (*reinterpret_cast<const bf16x8*>(p))
#define SLOAD_H(Kp, Vp, k0) do { st_v0 = LD8(ROW(Vp, k0, sr)); st_v1 = LD8(ROW(Vp, k0, 32 + sr)); st_k0 = LD8(ROW(Kp, k0, sr)); st_k1 = LD8(ROW(Kp, k0, 32 + sr)); } while (0)
#define SWRITE_H(bf) do { *(bf16x8*)(V_lds + (bf) * SHM_V + vst0) = st_v0; *(bf16x8*)(V_lds + (bf) * SHM_V + vst1) = st_v1; \
                          *(bf16x8*)(K_lds + (bf) * SHM_K + kws) = st_k0; *(bf16x8*)(K_lds + (bf) * SHM_K + kws + 32 * 256) = st_k1; } while (0)
template <int MODE>
__device__ __forceinline__ void attn_block(const BlockRef& cur, const int NT, const unsigned long long list, char* lds, const unsigned selbits) {
    int tid = threadIdx.x; asm volatile("" : "+v"(tid));
    const int wid = __builtin_amdgcn_readfirstlane(tid >> 6), lane = tid & 63, r32 = lane & 31, hi = lane >> 5;
    const int qlo = cur.P0 + wid * QBLK, qm = qlo + r32 - 4 * hi;
    char* V_lds = lds; char* K_lds = lds + 2 * SHM_V;
    float* ws = (float*)(lds + 2 * SHM_V + 2 * SHM_K) + wid * 64; float* li_l = ws, * al_l = ws + 32;
    const float* ncs = (const float*)(lds + LDS_CS);
    float m_reg = -1e30f, l_reg = 0; f32x16 o[4] = {};
    const int sr = tid >> 4, sc = (tid & 15) * 8, vst0 = v_st(sr, sc), vst1 = v_st(32 + sr, sc), kws = KSWZ(sr, sc * 2);
    const int vb0 = (int)(uintptr_t)V_lds + v_rd_base(lane);
    const bf16_t* Kh = cur.K; const bf16_t* Vh = cur.V;
    float cq = 0.f; if (MODE == 0) cq = -ncs[qlo + r32];
#define RESC(a) do { if (__any((a) < 1.f)) { if (hi == 0) al_l[r32] = (a); asm volatile("s_waitcnt lgkmcnt(0)" ::: "memory");              \
                     _Pragma("unroll") for (int d_ = 0; d_ < 4; ++d_) _Pragma("unroll") for (int r = 0; r < 16; ++r) o[d_][r] *= al_l[crow(r, hi)]; } } while (0)
#define KBASE(t) (MODE == 0 ? (NT - 1 - (t)) * KVBLK : (int)((list >> (4 * ((t) >> 2))) & 15ull) * 256 + (3 - ((t) & 3)) * KVBLK)
#define PREP(P0_, P1_, t, kb_) do { \
        if (MODE == 0) { if (kb_ + KVBLK - 1 > qlo) mask_tile(P0_, P1_, qm - kb_); } \
        else { if ((t) < 4) { if (kb_ + KVBLK - 1 > qlo) mask_tile(P0_, P1_, qm - kb_); } \
               else { const bool keep_ = (selbits >> (kb_ >> 8)) & 1u; const float NEG_ = -__builtin_inff(); \
                   _Pragma("unroll") for (int r_ = 0; r_ < 16; ++r_) { P0_[r_] = keep_ ? P0_[r_] : NEG_; P1_[r_] = keep_ ? P1_[r_] : NEG_; } } } } while (0)
    bf16x8 qr[8], st_v0, st_v1, st_k0, st_k1;
#pragma unroll
    for (int d0 = 0; d0 < 8; ++d0) qr[d0] = LD8(cur.Q + (size_t)(wid * QBLK + r32) * PITCH + d0 * 16 + hi * 8);
    SLOAD_H(Kh, Vh, KBASE(0)); VMW(); SWRITE_H(0);
    __syncthreads();
    f32x16 P0, P1; float al; bf16x8 pa0, pa1, pa2, pa3;
#define STEP(t, BUF) do { const int kbt_ = KBASE(t); \
        if ((t) + 1 < NT) { SLOAD_H(Kh, Vh, KBASE((t) + 1)); } SBAR(); \
        qkt<BUF, MODE>(P0, P1, K_lds, ncs + kbt_ + 4 * hi, r32, hi, qr); \
        PREP(P0, P1, t, kbt_); partialSM(P0, P1, m_reg, al, cq); RESC(al); finishSM(P0, P1, al, l_reg, pa0, pa1, pa2, pa3); SBAR(); \
        pv_tile<BUF>(o, vb0, pa0, pa1, pa2, pa3); \
        if ((t) + 1 < NT) { VMW(); SWRITE_H(1 - BUF); } \
        __syncthreads(); } while (0)
    for (int t = 0; t < NT; t += 2) { STEP(t, 0); STEP(t + 1, 1); }
    if (hi == 0) li_l[r32] = l_reg; asm volatile("s_waitcnt lgkmcnt(0)" ::: "memory");
    float rli[16];
#pragma unroll
    for (int r = 0; r < 16; ++r) rli[r] = __builtin_amdgcn_rcpf(li_l[crow(r, hi)]);
    bf16_t* Ow = cur.O + (size_t)(wid * QBLK) * PITCH;
#pragma unroll
    for (int r = 0; r < 16; ++r) { const int orow = crow(r, hi);
#pragma unroll
        for (int d0 = 0; d0 < 4; ++d0) { const float v = o[d0][r] * rli[r];
            const float vn = __shfl_xor(v, 1);
            if ((r32 & 1) == 0) *(unsigned*)(Ow + (size_t)orow * PITCH + d0 * 32 + r32) = cvtpk(v, vn); } }
    __syncthreads();
#undef RESC
#undef KBASE
#undef PREP
#undef STEP
}
#undef ROW
#undef VMW
#undef LD8
#undef SLOAD_H
#undef SWRITE_H
#undef KSWZ
#undef SBAR
}

struct Ctx {
    unsigned char* lds_g;
    LAS unsigned char* lds;
    unsigned char* ws; int tid, lane, wave, G, vcu;
};
#define WSP(T_, off) ((T_*)(C.ws + (off)))

__device__ __forceinline__ void cvt_item(const float* W, size_t ldw, int k0, int n0, bf16_t* WT, size_t Kd, int drow0, LAS unsigned* scr, int lane) {
    const float* src = W + (size_t)k0 * ldw + n0 + lane;
#pragma unroll
    for (int b = 0; b < 4; ++b) { float a[8], c[8];
#pragma unroll
        for (int i = 0; i < 8; ++i) { a[i] = src[(size_t)(2 * (b * 8 + i)) * ldw]; c[i] = src[(size_t)(2 * (b * 8 + i) + 1) * ldw]; }
#pragma unroll
        for (int i = 0; i < 8; ++i) scr[(b * 8 + i) * 65 + lane] = cvt_pk_bf16(a[i], c[i]); }
    LDS_WAIT(); asm volatile("" ::: "memory");
    const int ch = lane & 7;
#pragma unroll
    for (int p = 0; p < 8; ++p) { const int n = p * 8 + (lane >> 3); const LAS unsigned* s = scr + (4 * ch) * 65 + n;
        u32x4 w; w.x = s[0]; w.y = s[65]; w.z = s[130]; w.w = s[195];
        *(u32x4*)(WT + (size_t)(drow0 + n) * Kd + k0 + 8 * ch) = w; }
    LDS_WAIT(); asm volatile("" ::: "memory");
}
__device__ __forceinline__ float log_sigmoid(float z) { return fminf(z, 0.f) - log1pf(__expf(-fabsf(z))); }
__device__ __forceinline__ void fox_gate_row(const f32x4 (&xn)[4], const LAS float* fgT, const float* b_f, float* logf, int tok, int lane) {
    float p[8];
#pragma unroll
    for (int h = 0; h < 8; ++h) { float s = 0.f;
#pragma unroll
        for (int j = 0; j < 4; ++j) { const f32x4 w = *(const LAS f32x4*)(fgT + h * 1024 + lane * 4 + 256 * j); s += xn[j][0] * w[0] + xn[j][1] * w[1] + xn[j][2] * w[2] + xn[j][3] * w[3]; }
        p[h] = s; }
    const bool u5 = lane & 32, u4 = lane & 16, u3 = lane & 8;
    float q4[4], q2[2], q1;
#pragma unroll
    for (int i = 0; i < 4; ++i) { const float keep = u5 ? p[i + 4] : p[i], give = u5 ? p[i] : p[i + 4]; q4[i] = keep + __shfl_xor(give, 32); }
#pragma unroll
    for (int i = 0; i < 2; ++i) { const float keep = u4 ? q4[i + 2] : q4[i], give = u4 ? q4[i] : q4[i + 2]; q2[i] = keep + __shfl_xor(give, 16); }
    { const float keep = u3 ? q2[1] : q2[0], give = u3 ? q2[0] : q2[1]; q1 = keep + __shfl_xor(give, 8); }
    q1 += __shfl_xor(q1, 4); q1 += __shfl_xor(q1, 2); q1 += __shfl_xor(q1, 1);
    const int h = lane >> 3;
    if ((lane & 7) == 0) { const int b = tok >> 12, s = tok & 4095; logf[((size_t)b * 8 + h) * SEQ + s] = log_sigmoid(q1 + b_f[h]); }
}
__device__ __forceinline__ void stage_fgT(const Ctx& C, const float* w_in, LAS float* fgT) {
    for (int k = C.tid; k < 1024; k += NTHREADS) { const f32x4 a = *(const f32x4*)(w_in + (size_t)k * 3080 + 3072), b = *(const f32x4*)(w_in + (size_t)k * 3080 + 3076);
        fgT[0 * 1024 + k] = a[0]; fgT[1 * 1024 + k] = a[1]; fgT[2 * 1024 + k] = a[2]; fgT[3 * 1024 + k] = a[3];
        fgT[4 * 1024 + k] = b[0]; fgT[5 * 1024 + k] = b[1]; fgT[6 * 1024 + k] = b[2]; fgT[7 * 1024 + k] = b[3]; }
    LDS_WAIT(); __syncthreads();
}
__device__ __forceinline__ void phase_prologue(const Ctx& C, const float* const* in) {
    LAS unsigned* scr = (LAS unsigned*)(C.lds + C.wave * 8320);
    const int gw = C.vcu * NWAVES + C.wave, NGW = C.G * NWAVES;
    constexpr int I_FI = 16 * 48, I_FO = 16 * 16, I_RI = 16 * 96, I_RO = 32 * 16, I_W1 = 16 * 32, I_W2 = 16 * 16;
    constexpr int R0 = 2 * I_FI, R1 = R0 + 2 * I_FO, R2 = R1 + I_FI, R3 = R2 + I_FO, R4 = R3 + I_RI, R5 = R4 + I_RO, R6 = R5 + 128 * I_W1, R7 = R6 + 128 * I_W2;
    for (int it = gw; it < R7; it += NGW) {
        int r = it;
        if (r < R0) { const int j = r / I_FI; r -= j * I_FI; const int kb = r / 48, nb = r % 48;
            cvt_item(in[1] + (size_t)j * 1024 * 3080, 3080, kb * 64, nb * 64, WSP(bf16_t, WS_WFOXI) + (size_t)j * 3072 * 1024, 1024, nb * 64, scr, C.lane); continue; }
        if (r < R1) { r -= R0; const int j = r / I_FO; r -= j * I_FO; const int kb = r / 16, nb = r % 16;
            cvt_item(in[3] + (size_t)j * 1024 * 1024, 1024, kb * 64, nb * 64, WSP(bf16_t, WS_WFOXO) + (size_t)j * 1024 * 1024, 1024, nb * 64, scr, C.lane); continue; }
        if (r < R2) { r -= R1; const int kb = r / 48, nb = r % 48;
            cvt_item(in[4], 3072, kb * 64, nb * 64, WSP(bf16_t, WS_WMOBI), 1024, nb * 64, scr, C.lane); continue; }
        if (r < R3) { r -= R2; const int kb = r / 16, nb = r % 16;
            cvt_item(in[5], 1024, kb * 64, nb * 64, WSP(bf16_t, WS_WMOBO), 1024, nb * 64, scr, C.lane); continue; }
        if (r < R4) { r -= R3; const int kb = r / 96, nb = r % 96;
            cvt_item(in[6], 6144, kb * 64, nb * 64, WSP(bf16_t, WS_WRETI), 1024, nb * 64, scr, C.lane); continue; }
        if (r < R5) { r -= R4; const int kb = r / 16, nb = r % 16;
            cvt_item(in[8], 1024, kb * 64, nb * 64, WSP(bf16_t, WS_WRETO), 2048, nb * 64, scr, C.lane); continue; }
        if (r < R6) { r -= R5; const int le = r / I_W1; r -= le * I_W1; const int kb = r / 32, nb = r % 32; const int n0 = nb * 64;
            const int drow = (n0 < 1024) ? ((n0 >> 7) * 256 + (n0 & 127)) : ((((n0 - 1024) >> 7) * 256) + 128 + ((n0 - 1024) & 127));
            cvt_item(in[13] + (size_t)le * 1024 * 2048, 2048, kb * 64, n0, WSP(bf16_t, WS_W1T) + (size_t)le * 2048 * 1024, 1024, drow, scr, C.lane); continue; }
        { r -= R6; const int le = r / I_W2; r -= le * I_W2; const int kb = r / 16, nb = r % 16;
            cvt_item(in[15] + (size_t)le * 1024 * 1024, 1024, kb * 64, nb * 64, WSP(bf16_t, WS_W2T) + (size_t)le * 1024 * 1024, 1024, nb * 64, scr, C.lane); }
    }
    { float* cs = WSP(float, WS_TAB); float* sn = cs + 4096 * 128; float* csT = sn + 4096 * 128; float* snT = csT + 4096 * 128;
      for (int e = C.vcu * NTHREADS + C.tid; e < 4096 * 128; e += C.G * NTHREADS) { const int pos = e >> 7, j = e & 127;
          const float invf = expf(-9.210340371976184f * (float)(2 * j) / 256.0f); const float ang = (float)pos * invf;
          const float c = cosf(ang), s = sinf(ang); cs[e] = c; sn[e] = s; csT[(size_t)j * 4096 + pos] = c; snT[(size_t)j * 4096 + pos] = s; } }
    __syncthreads();
    LAS float* fgT = (LAS float*)C.lds;
    stage_fgT(C, in[1], fgT);
    for (int tok = gw; tok < T; tok += NGW) {
        const f32x4* xr = (const f32x4*)(in[0] + (size_t)tok * DM) + C.lane; f32x4 v[4];
#pragma unroll
        for (int j = 0; j < 4; ++j) v[j] = xr[64 * j];
        f32x4* xo = WSP(f32x4, WS_X) + (size_t)tok * (DM / 4) + C.lane; u32x2* xb = WSP(u32x2, WS_XB) + (size_t)tok * (DM / 4) + C.lane;
#pragma unroll
        for (int j = 0; j < 4; ++j) { xo[64 * j] = v[j]; u32x2 w; w.x = cvt_pk_bf16(v[j][0], v[j][1]); w.y = cvt_pk_bf16(v[j][2], v[j][3]); xb[64 * j] = w; }
        fox_gate_row(v, fgT, in[2], WSP(float, WS_MISC + MS_LOGF), tok, C.lane);
    }
}

__device__ __forceinline__ void phase_ln1_router(const Ctx& C, int li, const float* const* in) {
    LAS float* rwT = (LAS float*)C.lds;
    LAS int* cnt_l = (LAS int*)(C.lds + MISC_OFF + LM_CNT); LAS int* base_l = (LAS int*)(C.lds + MISC_OFF + LM_BASE);
    LAS int* te = (LAS int*)(C.lds + MISC_OFF + LM_TE); LAS int* tlp = (LAS int*)(C.lds + MISC_OFF + LM_TLP); LAS float* tg = (LAS float*)(C.lds + MISC_OFF + LM_TG);
    const float* rw = in[11] + (size_t)li * 1024 * 32; const float* rb = in[12] + li * 32;
    const float* g = in[9] + (size_t)(li * 2 + 0) * DM; const float* bt = in[10] + (size_t)(li * 2 + 0) * DM;
    unsigned* cnt_g = WSP(unsigned, WS_CTL) + CW_CNT + li * 32;
    for (int k = C.tid; k < 1024; k += NTHREADS) {
#pragma unroll
        for (int q = 0; q < 8; ++q) { const f32x4 a = *(const f32x4*)(rw + (size_t)k * 32 + 4 * q);
            rwT[(4 * q + 0) * 1024 + k] = a[0]; rwT[(4 * q + 1) * 1024 + k] = a[1]; rwT[(4 * q + 2) * 1024 + k] = a[2]; rwT[(4 * q + 3) * 1024 + k] = a[3]; } }
    f32x4 gv[4], bv[4];
#pragma unroll
    for (int j = 0; j < 4; ++j) { gv[j] = *((const f32x4*)g + C.lane + 64 * j); bv[j] = *((const f32x4*)bt + C.lane + 64 * j); }
    const float rbias = rb[C.lane >> 1];
    float* X = WSP(float, WS_X); const float* H = WSP(float, WS_H);
    for (int batch = C.vcu; batch < T / 64; batch += C.G) {
        if (C.tid < 32) cnt_l[C.tid] = 0;
        LDS_WAIT(); __syncthreads();
        for (int q = 0; q < 8; ++q) {
            const int tl = C.wave * 8 + q, tok = batch * 64 + tl;
            f32x4* xr = (f32x4*)(X + (size_t)tok * DM) + C.lane; const f32x4* hr = (const f32x4*)(H + (size_t)tok * DM) + C.lane;
            f32x4 v[4]; float s = 0.f;
#pragma unroll
            for (int j = 0; j < 4; ++j) { v[j] = xr[64 * j] * DN_ALPHA + hr[64 * j]; s += (v[j][0] + v[j][1]) + (v[j][2] + v[j][3]); }
            const float mean = wave_sum(s) * (1.f / DM); float s2 = 0.f;
#pragma unroll
            for (int j = 0; j < 4; ++j) { v[j] = v[j] - mean; s2 += (v[j][0] * v[j][0] + v[j][1] * v[j][1]) + (v[j][2] * v[j][2] + v[j][3] * v[j][3]); }
            const float rstd = 1.0f / sqrtf(wave_sum(s2) * (1.f / DM) + LN_EPS);
#pragma unroll
            for (int j = 0; j < 4; ++j) { v[j] = v[j] * rstd * gv[j] + bv[j]; xr[64 * j] = v[j]; }
            float p[32];
#pragma unroll
            for (int e = 0; e < 32; ++e) { float a = 0.f;
#pragma unroll
                for (int j = 0; j < 4; ++j) { const f32x4 w = *(const LAS f32x4*)(rwT + e * 1024 + C.lane * 4 + 256 * j); a += v[j][0] * w[0] + v[j][1] * w[1] + v[j][2] * w[2] + v[j][3] * w[3]; }
                p[e] = a; }
            const bool u5 = C.lane & 32, u4 = C.lane & 16, u3 = C.lane & 8, u2 = C.lane & 4, u1 = C.lane & 2;
            float q16[16], q8[8], q4[4], q2[2], lg;
#pragma unroll
            for (int i = 0; i < 16; ++i) { const float keep = u5 ? p[i + 16] : p[i], give = u5 ? p[i] : p[i + 16]; q16[i] = keep + __shfl_xor(give, 32); }
#pragma unroll
            for (int i = 0; i < 8; ++i) { const float keep = u4 ? q16[i + 8] : q16[i], give = u4 ? q16[i] : q16[i + 8]; q8[i] = keep + __shfl_xor(give, 16); }
#pragma unroll
            for (int i = 0; i < 4; ++i) { const float keep = u3 ? q8[i + 4] : q8[i], give = u3 ? q8[i] : q8[i + 4]; q4[i] = keep + __shfl_xor(give, 8); }
#pragma unroll
            for (int i = 0; i < 2; ++i) { const float keep = u2 ? q4[i + 2] : q4[i], give = u2 ? q4[i] : q4[i + 2]; q2[i] = keep + __shfl_xor(give, 4); }
            { const float keep = u1 ? q2[1] : q2[0], give = u1 ? q2[0] : q2[1]; lg = keep + __shfl_xor(give, 2); }
            lg += __shfl_xor(lg, 1);
            float val = (C.lane & 1) ? -__builtin_inff() : (lg + rbias);
            float tv[4]; int tix[4];
#pragma unroll
            for (int k = 0; k < 4; ++k) { const float m = wave_max(val); const unsigned long long bal = __ballot(val == m); const int ln = (int)__builtin_ctzll(bal);
                tv[k] = m; tix[k] = ln >> 1; if (C.lane == ln) val = -__builtin_inff(); }
            const float e1 = __expf(tv[1] - tv[0]), e2 = __expf(tv[2] - tv[0]), e3 = __expf(tv[3] - tv[0]); const float inv = 1.0f / (1.0f + e1 + e2 + e3);
            if (C.lane < 4) { const int e = C.lane == 0 ? tix[0] : C.lane == 1 ? tix[1] : C.lane == 2 ? tix[2] : tix[3];
                const float gt = (C.lane == 0 ? 1.0f : C.lane == 1 ? e1 : C.lane == 2 ? e2 : e3) * inv;
                const int lp = atomicAdd((int*)(cnt_l + e), 1);
                te[tl * 4 + C.lane] = e; tlp[tl * 4 + C.lane] = lp; tg[tl * 4 + C.lane] = gt; }
        }
        VM_WAIT(); LDS_WAIT(); __syncthreads();
        if (C.tid < 32) { const int n = cnt_l[C.tid]; base_l[C.tid] = n ? (int)__hip_atomic_fetch_add(cnt_g + C.tid, (unsigned)n, __ATOMIC_RELAXED, __HIP_MEMORY_SCOPE_AGENT) : 0; }
        __builtin_amdgcn_fence(__ATOMIC_ACQUIRE, "agent");
        VM_WAIT(); LDS_WAIT(); __syncthreads();
        int* tok_e = WSP(int, WS_MISC + MS_TOKE); int* tok_p = WSP(int, WS_MISC + MS_TOKP); float* tok_g = WSP(float, WS_MISC + MS_TOKG);
        for (int q = 0; q < 8; ++q) {
            const int tl = C.wave * 8 + q, tok = batch * 64 + tl;
            const f32x4* xr = (const f32x4*)(X + (size_t)tok * DM) + C.lane * 4;
            const f32x4 a = xr[0], b = xr[1], c = xr[2], d = xr[3];
            u32x4 w0, w1; w0.x = cvt_pk_bf16(a[0], a[1]); w0.y = cvt_pk_bf16(a[2], a[3]); w0.z = cvt_pk_bf16(b[0], b[1]); w0.w = cvt_pk_bf16(b[2], b[3]);
            w1.x = cvt_pk_bf16(c[0], c[1]); w1.y = cvt_pk_bf16(c[2], c[3]); w1.z = cvt_pk_bf16(d[0], d[1]); w1.w = cvt_pk_bf16(d[2], d[3]);
#pragma unroll
            for (int k = 0; k < 4; ++k) { const int e = te[tl * 4 + k]; const int pos = base_l[e] + tlp[tl * 4 + k];
                u32x4* dst = (u32x4*)(WSP(bf16_t, WS_XS) + ((size_t)e * ECAP + pos) * DM) + C.lane * 2; dst[0] = w0; dst[1] = w1;
                if (C.lane == k) { tok_e[tok * 4 + k] = e; tok_p[tok * 4 + k] = pos; tok_g[tok * 4 + k] = tg[tl * 4 + k]; } }
        }
        LDS_WAIT(); __syncthreads();
    }
}

__device__ __forceinline__ void phase_ln2(const Ctx& C, int li, const float* const* in, float* out, bool do_gate, const float* fox_w_in, const float* fox_b_f) {
    const float* g = in[9] + (size_t)(li * 2 + 1) * DM; const float* bt = in[10] + (size_t)(li * 2 + 1) * DM;
    LAS float* fgT = (LAS float*)C.lds;
    if (do_gate) stage_fgT(C, fox_w_in, fgT);
    f32x4 gv[4], bv[4];
#pragma unroll
    for (int j = 0; j < 4; ++j) { gv[j] = *((const f32x4*)g + C.lane + 64 * j); bv[j] = *((const f32x4*)bt + C.lane + 64 * j); }
    const int gw = C.vcu * NWAVES + C.wave, NGW = C.G * NWAVES;
    const int* tok_e = WSP(int, WS_MISC + MS_TOKE); const int* tok_p = WSP(int, WS_MISC + MS_TOKP); const float* tok_g = WSP(float, WS_MISC + MS_TOKG);
    float* X = WSP(float, WS_X); const bf16_t* Y = WSP(bf16_t, WS_XS);
    for (int tok = gw; tok < T; tok += NGW) {
        f32x4* xr = (f32x4*)(X + (size_t)tok * DM) + C.lane;
        int ek[4], pk[4]; float gk[4];
#pragma unroll
        for (int k = 0; k < 4; ++k) { ek[k] = tok_e[tok * 4 + k]; pk[k] = tok_p[tok * 4 + k]; gk[k] = tok_g[tok * 4 + k]; }
        f32x4 v[4];
#pragma unroll
        for (int j = 0; j < 4; ++j) v[j] = xr[64 * j] * DN_ALPHA;
#pragma unroll
        for (int k = 0; k < 4; ++k) { const u32x2* yr = (const u32x2*)(Y + ((size_t)ek[k] * ECAP + pk[k]) * DM) + C.lane;
#pragma unroll
            for (int j = 0; j < 4; ++j) { const u32x2 w = yr[64 * j]; v[j][0] += gk[k] * bflo(w.x); v[j][1] += gk[k] * bfhi(w.x); v[j][2] += gk[k] * bflo(w.y); v[j][3] += gk[k] * bfhi(w.y); } }
        float s = 0.f;
#pragma unroll
        for (int j = 0; j < 4; ++j) s += (v[j][0] + v[j][1]) + (v[j][2] + v[j][3]);
        const float mean = wave_sum(s) * (1.f / DM); float s2 = 0.f;
#pragma unroll
        for (int j = 0; j < 4; ++j) { v[j] = v[j] - mean; s2 += (v[j][0] * v[j][0] + v[j][1] * v[j][1]) + (v[j][2] * v[j][2] + v[j][3] * v[j][3]); }
        const float rstd = 1.0f / sqrtf(wave_sum(s2) * (1.f / DM) + LN_EPS);
        u32x2* xb = WSP(u32x2, WS_XB) + (size_t)tok * (DM / 4) + C.lane;
#pragma unroll
        for (int j = 0; j < 4; ++j) { v[j] = v[j] * rstd * gv[j] + bv[j]; xr[64 * j] = v[j];
            u32x2 w; w.x = cvt_pk_bf16(v[j][0], v[j][1]); w.y = cvt_pk_bf16(v[j][2], v[j][3]); xb[64 * j] = w;
            if (out) ((f32x4*)(out + (size_t)tok * DM) + C.lane)[64 * j] = v[j]; }
        if (do_gate) fox_gate_row(v, fgT, fox_b_f, WSP(float, WS_MISC + MS_LOGF), tok, C.lane);
    }
}

__device__ __forceinline__ void phase_kmean(const Ctx& C) {
    LAS float* red = (LAS float*)C.lds;
    const bf16_t* K = WSP(bf16_t, WS_K); float* KM = WSP(float, WS_MISC + MS_KMEAN);
    for (int u = C.vcu; u < 512; u += C.G) {
        const int bh = u >> 4, n = u & 15, b = bh >> 3, h = bh & 7; const int cg = C.tid & 15, rp = C.tid >> 4;
        float a[8] = {0.f, 0.f, 0.f, 0.f, 0.f, 0.f, 0.f, 0.f};
#pragma unroll
        for (int i = 0; i < 8; ++i) { const u32x4 w = *(const u32x4*)(K + ((size_t)b * SEQ + n * 256 + rp + 32 * i) * 1024 + h * 128 + cg * 8);
            a[0] += bflo(w.x); a[1] += bfhi(w.x); a[2] += bflo(w.y); a[3] += bfhi(w.y); a[4] += bflo(w.z); a[5] += bfhi(w.z); a[6] += bflo(w.w); a[7] += bfhi(w.w); }
#pragma unroll
        for (int i = 0; i < 8; ++i) red[rp * 128 + cg * 8 + i] = a[i];
        LDS_WAIT(); __syncthreads();
        if (C.tid < 128) { float s = 0.f;
#pragma unroll
            for (int r = 0; r < 32; ++r) s += red[r * 128 + C.tid];
            KM[(size_t)u * 128 + C.tid] = s * (1.0f / 256.0f); }
        LDS_WAIT(); __syncthreads();
    }
}

__device__ __forceinline__ void phase_ret_kT(const Ctx& C) {
    LAS unsigned short* tl = (LAS unsigned short*)(C.lds + C.wave * 8448);
    const bf16_t* Kp = WSP(bf16_t, WS_K); bf16_t* KT = WSP(bf16_t, WS_KT);
    const int gw = C.vcu * NWAVES + C.wave, NGW = C.G * NWAVES, ch = C.lane & 7, rr = C.lane >> 3;
    for (int it = gw; it < 256 * 16; it += NGW) {
        const int tt = it >> 4, ct = it & 15, tok0 = tt * 64, col0 = ct * 64, b = tok0 >> 12, s0 = tok0 & 4095;
#pragma unroll
        for (int p = 0; p < 8; ++p) { const int row = p * 8 + rr; const u32x4 w = *(const u32x4*)(Kp + (size_t)(tok0 + row) * 1024 + col0 + ch * 8);
            LAS unsigned short* d = tl + row * 66 + ch * 8;
            d[0] = (unsigned short)w.x; d[1] = (unsigned short)(w.x >> 16); d[2] = (unsigned short)w.y; d[3] = (unsigned short)(w.y >> 16);
            d[4] = (unsigned short)w.z; d[5] = (unsigned short)(w.z >> 16); d[6] = (unsigned short)w.w; d[7] = (unsigned short)(w.w >> 16); }
        LDS_WAIT(); asm volatile("" ::: "memory");
#pragma unroll
        for (int p = 0; p < 8; ++p) { const int c = p * 8 + rr; const LAS unsigned short* sp = tl + (ch * 8) * 66 + c;
            u32x4 w; w.x = (unsigned)sp[0] | ((unsigned)sp[66] << 16); w.y = (unsigned)sp[2 * 66] | ((unsigned)sp[3 * 66] << 16);
            w.z = (unsigned)sp[4 * 66] | ((unsigned)sp[5 * 66] << 16); w.w = (unsigned)sp[6 * 66] | ((unsigned)sp[7 * 66] << 16);
            *(u32x4*)(KT + ((size_t)b * 1024 + col0 + c) * 4096 + s0 + ch * 8) = w; }
        LDS_WAIT(); asm volatile("" ::: "memory");
    }
}

__device__ __forceinline__ void phase_ret_scan(const Ctx& C) {
    const float* UT = WSP(float, WS_UT); bf16_t* RT = WSP(bf16_t, WS_RT);
    for (int it = C.vcu * NTHREADS + C.tid; it < 16 * 512 * 32; it += C.G * NTHREADS) {
        const int bh = it >> 14, v = (it >> 5) & 511, d = (it & 31) * 8, h = bh & 3;
        const float G = __builtin_amdgcn_exp2f(256.0f * gamma_log2(h));
        f32x4 r0 = {0.f, 0.f, 0.f, 0.f}, r1 = {0.f, 0.f, 0.f, 0.f};
#pragma unroll 4
        for (int c = 0; c < 16; ++c) {
            u32x4 w; w.x = cvt_pk_bf16(r0[0], r0[1]); w.y = cvt_pk_bf16(r0[2], r0[3]); w.z = cvt_pk_bf16(r1[0], r1[1]); w.w = cvt_pk_bf16(r1[2], r1[3]);
            *(u32x4*)(RT + ((size_t)bh * 512 + v) * 4096 + c * 256 + d) = w;
            if (c < 15) { const float* up = UT + (((size_t)bh * 16 + c) * 512 + v) * 256 + d; const f32x4 u0 = *(const f32x4*)up, u1 = *(const f32x4*)(up + 4);
                r0 = (r0 + u0) * G; r1 = (r1 + u1) * G; }
        }
    }
}

__device__ __forceinline__ void phase_ret_gn(const Ctx& C, const float* gn_g) {
    const int gw = C.vcu * NWAVES + C.wave, NGW = C.G * NWAVES;
    const float* O = WSP(float, WS_O32); const bf16_t* SG = WSP(bf16_t, WS_SG); bf16_t* Y = WSP(bf16_t, WS_Y);
    for (int tok = gw; tok < T; tok += NGW) {
#pragma unroll
        for (int h = 0; h < 4; ++h) { const size_t off = (size_t)tok * 2048 + h * 512 + C.lane * 8;
            const f32x4 a = *(const f32x4*)(O + off), b = *(const f32x4*)(O + off + 4);
            const float s = wave_sum((a[0] + a[1]) + (a[2] + a[3]) + (b[0] + b[1]) + (b[2] + b[3])); const float mu = s * (1.f / 512.f);
            const f32x4 da = a - mu, db = b - mu;
            const float q = wave_sum((da[0] * da[0] + da[1] * da[1]) + (da[2] * da[2] + da[3] * da[3]) + (db[0] * db[0] + db[1] * db[1]) + (db[2] * db[2] + db[3] * db[3]));
            const float rstd = 1.0f / sqrtf(q * (1.f / 512.f) + 1e-6f);
            const f32x4 g0 = *(const f32x4*)(gn_g + h * 512 + C.lane * 8), g1 = *(const f32x4*)(gn_g + h * 512 + C.lane * 8 + 4);
            const u32x4 sg = *(const u32x4*)(SG + off);
            const float y0 = da[0] * rstd * g0[0] * bflo(sg.x), y1 = da[1] * rstd * g0[1] * bfhi(sg.x), y2 = da[2] * rstd * g0[2] * bflo(sg.y), y3 = da[3] * rstd * g0[3] * bfhi(sg.y);
            const float y4 = db[0] * rstd * g1[0] * bflo(sg.z), y5 = db[1] * rstd * g1[1] * bfhi(sg.z), y6 = db[2] * rstd * g1[2] * bflo(sg.w), y7 = db[3] * rstd * g1[3] * bfhi(sg.w);
            u32x4 w; w.x = cvt_pk_bf16(y0, y1); w.y = cvt_pk_bf16(y2, y3); w.z = cvt_pk_bf16(y4, y5); w.w = cvt_pk_bf16(y6, y7);
            *(u32x4*)(Y + off) = w; }
    }
}

template <int MODE>
__device__ __forceinline__ void phase_attention(const Ctx& C) {
    char* lds = (char*)C.lds_g;
    const bf16_t* Qb = WSP(bf16_t, WS_Q); const bf16_t* Kb = WSP(bf16_t, WS_K); const bf16_t* Vb = WSP(bf16_t, WS_V); bf16_t* Ob = WSP(bf16_t, WS_OA);
    const int lane = C.lane, r32 = lane & 31;
#pragma nounroll
    for (int L = C.vcu; L < 256; L += C.G) {
        const int bh = L >> 3, x = L & 7, b = bh >> 3, h = bh & 7;
        const size_t hoff = (size_t)b * SEQ * 1024 + h * 128;
        if (MODE == 0) {
            float* cs = (float*)(lds + att::LDS_CS); float* wt = (float*)(lds + MISC_OFF + LM_SCAN);
            const float* lf = WSP(float, WS_MISC + MS_LOGF) + (size_t)bh * SEQ + C.tid * 8;
            const f32x4 a = *(const f32x4*)lf, bq = *(const f32x4*)(lf + 4);
            float p[8]; p[0] = a[0]; p[1] = p[0] + a[1]; p[2] = p[1] + a[2]; p[3] = p[2] + a[3]; p[4] = p[3] + bq[0]; p[5] = p[4] + bq[1]; p[6] = p[5] + bq[2]; p[7] = p[6] + bq[3];
            float run = p[7];
#pragma unroll
            for (int o = 1; o < 64; o <<= 1) { const float t = __shfl_up(run, o); if (lane >= o) run += t; }
            if (lane == 63) wt[C.wave] = run;
            LDS_WAIT(); __syncthreads();
            float off = run - p[7];
            for (int w = 0; w < C.wave; ++w) off += wt[w];
#pragma unroll
            for (int i = 0; i < 8; ++i) cs[C.tid * 8 + i] = -(off + p[i]) * (1.0f / att::SCALE);
            LDS_WAIT(); __syncthreads();
        }
#pragma nounroll
        for (int pss = 0; pss < 2; ++pss) {
            const int qbc = pss ? 15 - x : x;
            att::BlockRef cur;
            cur.Q = Qb + hoff + (size_t)qbc * 256 * 1024; cur.O = Ob + hoff + (size_t)qbc * 256 * 1024; cur.K = Kb + hoff; cur.V = Vb + hoff; cur.P0 = qbc * 256;
            const int qb = cur.P0 >> 8;
            int NT; unsigned long long list = 0ull; unsigned selbits = 0u;
            if (MODE == 0) { NT = 4 * (qb + 1); }
            else {
                LAS unsigned* sel = (LAS unsigned*)(C.lds + MISC_OFF + LM_SEL); LAS unsigned* uni = (LAS unsigned*)(C.lds + MISC_OFF + LM_UNI);
                LAS float* km = (LAS float*)(C.lds + att::LDS_CS);
                if (C.tid == 0) uni[0] = 0u;
                const float* KM = WSP(float, WS_MISC + MS_KMEAN) + (size_t)bh * 16 * 128;
                for (int i = C.tid; i < qb * 32; i += NTHREADS) *(LAS f32x4*)(km + i * 4) = *(const f32x4*)(KM + i * 4);
                LDS_WAIT(); __syncthreads();
                const int row = C.tid >> 1, half = C.tid & 1;
                unsigned bits;
                if (qb <= 3) bits = (1u << qb) - 1u;
                else {
                    float qv[64];
                    const u32x4* qp = (const u32x4*)(cur.Q + (size_t)row * 1024 + half * 64);
#pragma unroll
                    for (int i = 0; i < 8; ++i) { const u32x4 w = qp[i]; qv[8 * i + 0] = bflo(w.x); qv[8 * i + 1] = bfhi(w.x); qv[8 * i + 2] = bflo(w.y); qv[8 * i + 3] = bfhi(w.y);
                        qv[8 * i + 4] = bflo(w.z); qv[8 * i + 5] = bfhi(w.z); qv[8 * i + 6] = bflo(w.w); qv[8 * i + 7] = bfhi(w.w); }
                    float v0 = -__builtin_inff(), v1 = v0, v2 = v0; int i0 = 0, i1 = 0, i2 = 0;
                    for (int n = 0; n < qb; ++n) { const LAS float* kp = km + n * 128 + half * 64; float dsum = 0.f;
#pragma unroll
                        for (int i = 0; i < 16; ++i) { const f32x4 kk = *(const LAS f32x4*)(kp + 4 * i); dsum += qv[4 * i] * kk[0] + qv[4 * i + 1] * kk[1] + qv[4 * i + 2] * kk[2] + qv[4 * i + 3] * kk[3]; }
                        dsum += __shfl_xor(dsum, 1);
                        if (dsum > v0) { v2 = v1; i2 = i1; v1 = v0; i1 = i0; v0 = dsum; i0 = n; }
                        else if (dsum > v1) { v2 = v1; i2 = i1; v1 = dsum; i1 = n; }
                        else if (dsum > v2) { v2 = dsum; i2 = n; } }
                    bits = (1u << i0) | (1u << i1) | (1u << i2);
                }
                if (half == 0) { sel[row] = bits; }
                unsigned ub = bits;
#pragma unroll
                for (int o = 1; o < 64; o <<= 1) ub |= __shfl_xor(ub, o);
                if (lane == 0) atomicOr((unsigned*)uni, ub);
                LDS_WAIT(); __syncthreads();
                selbits = sel[C.wave * 32 + r32];
                const unsigned un = __builtin_amdgcn_readfirstlane(uni[0]);
                list = (unsigned long long)qb; int nb = 1;
                for (int n = qb - 1; n >= 0; --n) if ((un >> n) & 1u) { list |= (unsigned long long)n << (4 * nb); ++nb; }
                NT = 4 * nb;
            }
            att::attn_block<MODE>(cur, NT, list, lds, selbits);
        }
    }
}

struct Args { const float* in[17]; float* out; unsigned char* ws; int ph_lo, ph_hi; };
constexpr int N_PHASES = 34;


#undef WSP
#define WSP(T_, off) ((T_*)(P.ws + (off)))
#define PHASE_IF if (ph >= lo && ph < hi)
#define PHASE_CTX Ctx P = C; { GAS unsigned char* w_ = (GAS unsigned char*)args.ws; asm volatile("" : "+s"(w_)); P.ws = (unsigned char*)w_; int t_ = threadIdx.x; asm volatile("" : "+v"(t_)); P.tid = t_; P.lane = t_ & 63; }
#define PHASE_END do { if (ph >= lo && ph + 1 < hi) { XcdBarrier b_ = bar; GAS unsigned* p_ = (GAS unsigned*)b_.bar; asm volatile("" : "+s"(p_)); b_.bar = (unsigned*)p_; xcd_barrier(b_); } ++ph; } while (0)
template <int li>
__device__ __forceinline__ void layer_body(const Ctx& C, const Args& args, const XcdBarrier& bar, const int lo, const int hi, int& ph) {
    const float* const* in = args.in; LAS unsigned char* ring = C.lds; const int G = C.G, bx = (int)blockIdx.x;
        const int kind = li % 3;
        if (kind != 2) {
            PHASE_IF { PHASE_CTX; const bf16_t* W = (kind == 0) ? WSP(bf16_t, WS_WFOXI) + (size_t)(li / 3) * 3072 * 1024 : WSP(bf16_t, WS_WMOBI);
                pg8::DenseOrder S; S.init(WSP(bf16_t, WS_XB), W, T, 3072, 1024, 1024, G, bx); pg8::EpiQKV E{WSP(bf16_t, WS_Q)};
                pg8::gemm_phase(ring, 1024, 1024, 1024, S, E); }
            PHASE_END;
            if (kind == 1) { PHASE_IF { PHASE_CTX; phase_kmean(P); } PHASE_END; }
            PHASE_IF { PHASE_CTX; if (kind == 0) phase_attention<0>(P); else phase_attention<1>(P); }
            PHASE_END;
            PHASE_IF { PHASE_CTX; const bf16_t* W = (kind == 0) ? WSP(bf16_t, WS_WFOXO) + (size_t)(li / 3) * 1024 * 1024 : WSP(bf16_t, WS_WMOBO);
                pg8::DenseOrder S; S.init(WSP(bf16_t, WS_OA), W, T, 1024, 1024, 1024, G, bx); pg8::EpiF32 E{WSP(float, WS_H), 1024};
                pg8::gemm_phase(ring, 1024, 1024, 1024, S, E); }
            PHASE_END;
        } else {
            PHASE_IF { PHASE_CTX;
                const float* tab = WSP(float, WS_TAB);
                { pg8::DenseOrder S; S.init(WSP(bf16_t, WS_XB), WSP(bf16_t, WS_WRETI), T, 2048, 1024, 1024, G, bx);
                  pg8::EpiRope E{WSP(bf16_t, WS_Q), WSP(bf16_t, WS_K), tab, tab + 4096 * 128}; pg8::gemm_phase(ring, 1024, 1024, 1024, S, E); }
                { pg8::DenseOrder S; S.init(WSP(bf16_t, WS_WRETI) + (size_t)2048 * 1024, WSP(bf16_t, WS_XB), 2048, T, 1024, 1024, G, bx);
                  pg8::EpiSwap E{WSP(bf16_t, WS_VT)}; pg8::gemm_phase(ring, 1024, 1024, 1024, S, E); }
                { pg8::DenseOrder S; S.init(WSP(bf16_t, WS_XB), WSP(bf16_t, WS_WRETI) + (size_t)4096 * 1024, T, 2048, 1024, 1024, G, bx);
                  pg8::EpiSilu E{WSP(bf16_t, WS_SG)}; pg8::gemm_phase(ring, 1024, 1024, 1024, S, E); }
            }
            PHASE_END;
            PHASE_IF { PHASE_CTX;
                { pg8::RetSOrder S{(const char*)WSP(bf16_t, WS_Q), (const char*)WSP(bf16_t, WS_K), G, bx}; pg8::EpiSMask E{WSP(bf16_t, WS_SP)}; pg8::gemm_phase(ring, 256, 1024, 1024, S, E); }
                phase_ret_kT(P);
            }
            PHASE_END;
            PHASE_IF { PHASE_CTX; pg8::RetUOrder S{(const char*)WSP(bf16_t, WS_VT), (const char*)WSP(bf16_t, WS_KT), G, bx}; pg8::EpiUT E{WSP(float, WS_UT)}; pg8::gemm_phase(ring, 256, 4096, 4096, S, E); }
            PHASE_END;
            PHASE_IF { PHASE_CTX; phase_ret_scan(P); }
            PHASE_END;
            PHASE_IF { PHASE_CTX; pg8::RetOOrder S{(const char*)WSP(bf16_t, WS_Q), (const char*)WSP(bf16_t, WS_SP), (const char*)WSP(bf16_t, WS_RT), (const char*)WSP(bf16_t, WS_VT), G, bx};
                pg8::EpiRetO E{WSP(float, WS_O32)}; pg8::gemm_phase(ring, 256, 1024, 4096, S, E); }
            PHASE_END;
            PHASE_IF { PHASE_CTX; phase_ret_gn(P, in[7]); }
            PHASE_END;
            PHASE_IF { PHASE_CTX; pg8::DenseOrder S; S.init(WSP(bf16_t, WS_Y), WSP(bf16_t, WS_WRETO), T, 1024, 2048, 2048, G, bx); pg8::EpiF32 E{WSP(float, WS_H), 1024};
                pg8::gemm_phase(ring, 2048, 2048, 2048, S, E); }
            PHASE_END;
        }
        PHASE_IF { PHASE_CTX; phase_ln1_router(P, li, in); }
        PHASE_END;
        for (int mm = 0; mm < 2; ++mm) {
            PHASE_IF { PHASE_CTX;
                LAS int* tstart = (LAS int*)(P.lds + MISC_OFF + LM_TSTART);
                if (P.tid < 64) { const unsigned* cnt = WSP(unsigned, WS_CTL) + CW_CNT + li * 32; int nt_ = 0; if (P.lane < 32) nt_ = ((int)__hip_atomic_load(cnt + P.lane, __ATOMIC_RELAXED, __HIP_MEMORY_SCOPE_AGENT) + 255) >> 8;
                    int inc = nt_;
#pragma unroll
                    for (int o = 1; o < 32; o <<= 1) { const int t_ = __shfl_up(inc, o); if (P.lane >= o) inc += t_; }
                    if (P.lane < 32) tstart[P.lane + 1] = inc; if (P.lane == 0) tstart[0] = 0; }
                LDS_WAIT(); __syncthreads();
                const int ntiles = tstart[32];
                if (mm == 0) { pg8::MoeOrder S{(const char*)WSP(bf16_t, WS_XS), (const char*)(WSP(bf16_t, WS_W1T) + (size_t)li * 32 * 2048 * 1024), tstart, (size_t)2048 * 1024 * 2, ntiles, 8, G, bx, 1024u};
                    pg8::EpiSwiglu E{WSP(bf16_t, WS_ACT), in[14] + (size_t)li * 32 * 2048}; pg8::gemm_phase(ring, 1024, 1024, 1024, S, E); }
                else { pg8::MoeOrder S{(const char*)WSP(bf16_t, WS_ACT), (const char*)(WSP(bf16_t, WS_W2T) + (size_t)li * 32 * 1024 * 1024), tstart, (size_t)1024 * 1024 * 2, ntiles, 4, G, bx, 1024u};
                    pg8::EpiY E{WSP(bf16_t, WS_XS), in[16] + (size_t)li * 32 * 1024}; pg8::gemm_phase(ring, 1024, 1024, 1024, S, E); }
            }
            PHASE_END;
        }
        PHASE_IF { PHASE_CTX; phase_ln2(P, li, in, li == 3 ? args.out : nullptr, li == 2, in[1] + (size_t)1 * 1024 * 3080, in[2] + 8); }
        PHASE_END;
    }
__global__ void __launch_bounds__(NTHREADS, 2) mk_fwd(Args args) {
    extern __shared__ __attribute__((aligned(16))) unsigned char lds_raw[];
    Ctx C; C.lds_g = lds_raw; C.lds = (LAS unsigned char*)lds_raw; C.ws = args.ws;
    C.tid = threadIdx.x; C.lane = C.tid & 63; C.wave = __builtin_amdgcn_readfirstlane(C.tid >> 6); C.G = gridDim.x;
    { const int bx = blockIdx.x; C.vcu = (C.G % 8 == 0) ? (bx % 8) * (C.G / 8) + bx / 8 : bx; }
    const float* const* in = args.in;
    for (int u = C.tid; u < (LDS_BYTES - MISC_OFF) / 4; u += NTHREADS) ((LAS unsigned*)(C.lds + MISC_OFF))[u] = 0u;
    __syncthreads();
    unsigned* ctl0 = (unsigned*)(args.ws + WS_CTL);
    XcdBarrier bar = xcd_barrier_post(ctl0 + CW_BAR, (volatile LAS unsigned*)(C.lds + MISC_OFF + LM_BAR));
    const int lo = args.ph_lo, hi = args.ph_hi;
    int ph = 0;
    LAS unsigned char* ring = C.lds;
    const int G = C.G, bx = (int)blockIdx.x;

    PHASE_IF { PHASE_CTX; phase_prologue(P, in); }
    PHASE_END;

    layer_body<0>(C, args, bar, lo, hi, ph);
    layer_body<1>(C, args, bar, lo, hi, ph);
    layer_body<2>(C, args, bar, lo, hi, ph);
    layer_body<3>(C, args, bar, lo, hi, ph);
}
#undef PHASE_IF
#undef PHASE_END

extern "C" void kernel_launch(void* const* d_in, const int* in_sizes, int n_in, void* d_out, int out_size, void* d_ws, size_t ws_size, hipStream_t stream) {
    static int grid = 0;
    if (grid == 0) {
        if (n_in != 17 || out_size != T * DM || ws_size < WS_END) { fprintf(stderr, "kernel_launch: unexpected shapes (n_in %d out %d ws %zu)\n", n_in, out_size, ws_size); grid = -1; return; }
        int dev = 0, cus = 0;
        if (hipGetDevice(&dev) != hipSuccess || hipDeviceGetAttribute(&cus, hipDeviceAttributeMultiprocessorCount, dev) != hipSuccess) { grid = -1; return; }
        if (hipFuncSetAttribute((const void*)mk_fwd, hipFuncAttributeMaxDynamicSharedMemorySize, LDS_BYTES) != hipSuccess) { fprintf(stderr, "kernel_launch: hipFuncSetAttribute failed\n"); grid = -1; return; }
        int per_cu = 0;
        if (hipOccupancyMaxActiveBlocksPerMultiprocessor(&per_cu, (const void*)mk_fwd, NTHREADS, LDS_BYTES) != hipSuccess || per_cu < 1) fprintf(stderr, "kernel_launch: occupancy query says %d\n", per_cu);
        (void)hipGetLastError();
        grid = cus;
    }
    if (grid < 0) return;
    (void)hipMemsetAsync((char*)d_ws + WS_CTL, 0, CTL_BYTES, stream);
    Args a{};
    for (int i = 0; i < 17; ++i) a.in[i] = (const float*)d_in[i];
    a.out = (float*)d_out; a.ws = (unsigned char*)d_ws;
#if defined(MK_PER_PHASE)
    for (int p = 0; p < N_PHASES; ++p) { a.ph_lo = p; a.ph_hi = p + 1; hipLaunchKernelGGL(mk_fwd, dim3(grid), dim3(NTHREADS), LDS_BYTES, stream, a); }
#else
    a.ph_lo = 0; a.ph_hi = N_PHASES;
    hipLaunchKernelGGL(mk_fwd, dim3(grid), dim3(NTHREADS), LDS_BYTES, stream, a);
#endif
    const hipError_t le = hipPeekAtLastError();
    if (le != hipSuccess) fprintf(stderr, "kernel_launch: launch failed: %s\n", hipGetErrorName(le));
}
```

```cpp
#include <hip/hip_runtime.h>
#include <cstdio>
#include <cstdint>

#define GAS __attribute__((address_space(1)))
#define LAS __attribute__((address_space(3)))
typedef unsigned short bf16_t;
typedef short bf16x8 __attribute__((ext_vector_type(8)));
typedef short s16x4 __attribute__((ext_vector_type(4)));
typedef float f32x2 __attribute__((ext_vector_type(2)));
typedef float f32x4 __attribute__((ext_vector_type(4)));
typedef float f32x16 __attribute__((ext_vector_type(16)));
typedef unsigned u32x2 __attribute__((ext_vector_type(2)));
typedef unsigned u32x4 __attribute__((ext_vector_type(4)));

constexpr int NB = 4, SEQ = 4096, DM = 1024, T = NB * SEQ;
constexpr int NE = 32, ECAP = T;
constexpr float DN_ALPHA = 1.6817928305074290f;
constexpr float LN_EPS = 1e-5f;
constexpr int NWAVES = 8, NTHREADS = 512;

constexpr size_t MiB = 1ull << 20;
constexpr size_t WS_CTL = 0, CTL_BYTES = 4 * MiB;
constexpr size_t WS_WFOXI = 4 * MiB;
constexpr size_t WS_WFOXO = 16 * MiB;
constexpr size_t WS_WMOBI = 20 * MiB;
constexpr size_t WS_WMOBO = 26 * MiB;
constexpr size_t WS_WRETI = 28 * MiB;
constexpr size_t WS_WRETO = 40 * MiB;
constexpr size_t WS_TAB = 44 * MiB;
constexpr size_t WS_MISC = 52 * MiB;
constexpr size_t WS_W1T = 56 * MiB;
constexpr size_t WS_W2T = 568 * MiB;
constexpr size_t WS_X = 824 * MiB;
constexpr size_t WS_XB = 888 * MiB;
constexpr size_t WS_H = 920 * MiB;
constexpr size_t WS_Q = 984 * MiB;
constexpr size_t WS_K = 1016 * MiB;
constexpr size_t WS_V = 1048 * MiB;
constexpr size_t WS_OA = 1080 * MiB;
constexpr size_t WS_KT = 1112 * MiB;
constexpr size_t WS_VT = 1144 * MiB;
constexpr size_t WS_SG = 1208 * MiB;
constexpr size_t WS_SP = 1272 * MiB;
constexpr size_t WS_UT = 1304 * MiB;
constexpr size_t WS_RT = 1432 * MiB;
constexpr size_t WS_O32 = 1496 * MiB;
constexpr size_t WS_Y = 1624 * MiB;
constexpr size_t WS_XS = 1688 * MiB;
constexpr size_t WS_ACT = 2712 * MiB;
constexpr size_t WS_END = 3736 * MiB;
constexpr size_t MS_LOGF = 0, MS_KMEAN = 512 * 1024, MS_TOKE = 768 * 1024, MS_TOKP = 1024 * 1024, MS_TOKG = 1280 * 1024;
constexpr int CW_BAR = 4096, CW_CNT = 16384;

constexpr int RING_BYTES = 131072, MISC_OFF = RING_BYTES, LDS_BYTES = 147456;
constexpr int LM_BAR = 0, LM_TSTART = 64, LM_CNT = 256, LM_BASE = 384, LM_TE = 512, LM_TLP = 1536, LM_TG = 2560, LM_SCAN = 4096, LM_SEL = 4352, LM_UNI = 5376;

#define LDS_WAIT() asm volatile("s_waitcnt lgkmcnt(0)" ::: "memory")
#define VM_WAIT() asm volatile("s_waitcnt vmcnt(0)" ::: "memory")
__device__ __forceinline__ unsigned cvt_pk_bf16(float lo, float hi) { unsigned r; asm volatile("v_cvt_pk_bf16_f32 %0, %1, %2" : "=v"(r) : "v"(lo), "v"(hi)); return r; }
__device__ __forceinline__ float bf2f(unsigned short b) { return __uint_as_float(((unsigned)b) << 16); }
__device__ __forceinline__ float bflo(unsigned w) { return __uint_as_float(w << 16); }
__device__ __forceinline__ float bfhi(unsigned w) { return __uint_as_float(w & 0xffff0000u); }
__device__ __forceinline__ float wave_sum(float v) {
#pragma unroll
    for (int o = 1; o < 64; o <<= 1) v += __shfl_xor(v, o);
    return v;
}
__device__ __forceinline__ float wave_max(float v) {
#pragma unroll
    for (int o = 1; o < 64; o <<= 1) v = fmaxf(v, __shfl_xor(v, o));
    return v;
}
__device__ __forceinline__ float gamma_log2(int h) { return __builtin_log2f(1.0f - __builtin_exp2f(-5.0f - (float)h)); }

#define XB_TMO      128
#define XB_XCNT(j)  (256  + 64 * (j))
#define XB_XSUB(j)  (1280 + 64 * (j))
#define XB_XGEN(j)  (2304 + 64 * (j))
#define XB_TOP      3328
#define XB_TOPGEN   3392
#define XCD_BAR_WORDS 3456
#define XB_SPIN_CAP (1u << 18)
__device__ __forceinline__ unsigned xb_ld(unsigned* p)              { return __hip_atomic_load(p, __ATOMIC_RELAXED, __HIP_MEMORY_SCOPE_AGENT); }
__device__ __forceinline__ unsigned xb_add(unsigned* p, unsigned v) { return __hip_atomic_fetch_add(p, v, __ATOMIC_RELAXED, __HIP_MEMORY_SCOPE_AGENT); }
__device__ __forceinline__ unsigned xb_xcc_id() { return (unsigned)__builtin_amdgcn_s_getreg((3 << 11) | 20) & 0xFu; }
#define XB_SPIN(cond, bar) do { unsigned _sp = 0; while (cond) { __builtin_amdgcn_s_sleep(1); \
    if ((++_sp & 255u) == 0u) { if (xb_ld(&(bar)[XB_TMO])) break; if (_sp > XB_SPIN_CAP) { atomicAdd(&(bar)[XB_TMO], 1u); break; } } } } while (0)
struct XcdBarrier { unsigned* bar; unsigned x; volatile LAS unsigned* st; };
__device__ __forceinline__ XcdBarrier xcd_barrier_post(unsigned* bar, volatile LAS unsigned* st) {
    XcdBarrier b; b.bar = bar; b.x = xb_xcc_id(); b.st = st;
    if (threadIdx.x == 0) (void)xb_add(&bar[XB_XCNT(b.x)], 1u);
    return b;
}
__device__ __forceinline__ void xcd_barrier_complete(unsigned* bar, unsigned x, unsigned& nloc, unsigned& nx) {
    const unsigned G = gridDim.x * gridDim.y * gridDim.z;
    unsigned sum, cnt, mine, sp = 0u;
    for (;;) {
        sum = 0u; cnt = 0u; mine = 0u;
#pragma unroll
        for (unsigned j = 0; j < 16; ++j) { const unsigned c = xb_ld(&bar[XB_XCNT(j)]); sum += c; cnt += (c > 0u) ? 1u : 0u; mine = (j == x) ? c : mine; }
        if (sum == G) break;
        __builtin_amdgcn_s_sleep(1);
        if ((++sp & 255u) == 0u) { if (xb_ld(&bar[XB_TMO])) break; if (sp > XB_SPIN_CAP) { atomicAdd(&bar[XB_TMO], 1u); break; } }
    }
    nloc = mine > 0u ? mine : 1u; nx = cnt > 0u ? cnt : 1u;
}
__device__ __forceinline__ void xcd_barrier(const XcdBarrier& b) {
    asm volatile("s_waitcnt vmcnt(0)" ::: "memory");
    __syncthreads();
    if (threadIdx.x == 0) {
        unsigned* bar = b.bar;
        __builtin_amdgcn_s_waitcnt(0);
        unsigned nloc = b.st[0], nx = b.st[1];
        if (nloc == 0u) { xcd_barrier_complete(bar, b.x, nloc, nx); b.st[0] = nloc; b.st[1] = nx; }
        const unsigned old = xb_add(&bar[XB_XSUB(b.x)], 1u);
        const unsigned gen = old / nloc;
        if (old + 1u == (gen + 1u) * nloc) {
            __builtin_amdgcn_fence(__ATOMIC_RELEASE, "agent");
            asm volatile("s_waitcnt vmcnt(0)" ::: "memory");
            const unsigned og = xb_add(&bar[XB_TOP], 1u);
            const unsigned tg = og / nx;
            if (og + 1u == (tg + 1u) * nx) xb_add(&bar[XB_TOPGEN], 1u);
            else XB_SPIN(xb_ld(&bar[XB_TOPGEN]) == tg, bar);
            __builtin_amdgcn_fence(__ATOMIC_ACQUIRE, "agent");
            xb_add(&bar[XB_XGEN(b.x)], 1u);
            asm volatile("s_waitcnt vmcnt(0)" ::: "memory");
        } else {
            XB_SPIN(xb_ld(&bar[XB_XGEN(b.x)]) == gen, bar);
            __builtin_amdgcn_fence(__ATOMIC_ACQUIRE, "agent");
            asm volatile("s_waitcnt vmcnt(0)" ::: "memory");
        }
    }
    __syncthreads();
}

namespace pg8 {
constexpr int BM = 256, BK = 64, HALF = 128, HTB = HALF * BK * 2, STAGE_BYTES = 8 * HTB;
__device__ __forceinline__ int lds_byte(int r, int c) { const int st = (r >> 4) * 2 + (c >> 5), rr = r & 15, cc = c & 31, ob = rr * 64 + cc * 2; return st * 1024 + (ob ^ (((ob >> 9) & 1) << 5)); }
__device__ __forceinline__ void stage_rc(int b, int& R, int& C) { const int st = b / 1024, sb = b % 1024, swz = sb ^ (((sb >> 9) & 1) << 5); R = (st >> 1) * 16 + swz / 64; C = (st & 1) * 32 + (swz % 64) / 2; }
__device__ __forceinline__ int perm32(int rho) { const int n = rho >> 4, i = rho & 15; return 8 * (i >> 2) + 4 * n + (i & 3); }
struct Item { const char* A; const char* B; int pm, pn, aux; bool first, last; };

template <class Epi, class Sched>
__device__ __forceinline__ void gemm_phase(LAS unsigned char* lds, const int K, const unsigned pitchA, const unsigned pitchB, const Sched& S, const Epi& E) {
    int tid = threadIdx.x; asm volatile("" : "+v"(tid));
    const int wid = __builtin_amdgcn_readfirstlane(tid >> 6), lane = tid & 63, wr = wid >> 2, wc = wid & 3, fr = lane & 15, fq = lane >> 4;
    const int nt = K / BK;
    unsigned voffA[2], voffB[2];
#pragma unroll
    for (int i = 0; i < 2; ++i) { int R, C; stage_rc(tid * 16 + i * 8192, R, C); const int Rb = Epi::PERM ? ((R & ~31) + perm32(R & 31)) : R;
        voffA[i] = (unsigned)(R * pitchA + C) * 2u; voffB[i] = (unsigned)(Rb * pitchB + C) * 2u; }
    const size_t kstep = (size_t)(BK * 2);
    const size_t hstepA = (size_t)HALF * pitchA * 2, hstepB = (size_t)HALF * pitchB * 2;
    const unsigned ldsw = (unsigned)wid * 1024u;
    const int aoff = lds_byte(wr * 64 + fr, fq * 8), boff = lds_byte(wc * 32 + fr, fq * 8);
#define PG8_SA(b, h) (((b) * 2 + (h)) * HTB)
#define PG8_SB(b, h) ((4 + (b) * 2 + (h)) * HTB)
#define PG8_STAGE(bufoff, gbase, voff) do { _Pragma("unroll") for (int _i = 0; _i < 2; ++_i) \
        __builtin_amdgcn_global_load_lds((const unsigned*)((const char*)(gbase) + (voff)[_i]), (LAS unsigned*)(lds + (bufoff) + ldsw + _i * 8192), 16, 0, 0); } while (0)
#define PG8_LDA(dst, b, h) do { _Pragma("unroll") for (int m = 0; m < 4; ++m) _Pragma("unroll") for (int k = 0; k < 2; ++k) dst[m][k] = *(const LAS bf16x8*)(lds + PG8_SA(b, h) + aoff + m * 2048 + k * 1024); } while (0)
#define PG8_LDB(dst, b, h) do { _Pragma("unroll") for (int n = 0; n < 2; ++n) _Pragma("unroll") for (int k = 0; k < 2; ++k) dst[n][k] = *(const LAS bf16x8*)(lds + PG8_SB(b, h) + boff + n * 2048 + k * 1024); } while (0)
#define PG8_MMA(ai, bj, At, Bt) do { __builtin_amdgcn_s_setprio(1); _Pragma("unroll") for (int m = 0; m < 4; ++m) _Pragma("unroll") for (int n = 0; n < 2; ++n) _Pragma("unroll") for (int k = 0; k < 2; ++k) \
        acc[ai][bj][m][n] = __builtin_amdgcn_mfma_f32_16x16x32_bf16(Bt[n][k], At[m][k], acc[ai][bj][m][n], 0, 0, 0); __builtin_amdgcn_s_setprio(0); } while (0)
#define PG8_WAIT_V(n) asm volatile("s_waitcnt vmcnt(" #n ")" ::: "memory")
#define PG8_WAIT_L(n) asm volatile("s_waitcnt lgkmcnt(" #n ")" ::: "memory")
#define PG8_BAR __builtin_amdgcn_s_barrier()
#define PG8_SCHED __builtin_amdgcn_sched_barrier(0)
#define PG8_ZERO() do { _Pragma("unroll") for (int a = 0; a < 2; ++a) _Pragma("unroll") for (int b = 0; b < 2; ++b) _Pragma("unroll") for (int m = 0; m < 4; ++m) _Pragma("unroll") for (int n = 0; n < 2; ++n) acc[a][b][m][n] = (f32x4){0.f, 0.f, 0.f, 0.f}; } while (0)
    Item cur, nxt; int ui = 0;
    if (!S.next(0, cur)) return;
    f32x4 acc[2][2][4][2];
    PG8_ZERO();
    bf16x8 At[4][2], B0[2][2], B1[2][2];
    const char* cA = cur.A; const char* cB = cur.B;
    PG8_STAGE(PG8_SB(0, 0), cB, voffB); PG8_STAGE(PG8_SA(0, 0), cA, voffA); PG8_STAGE(PG8_SB(0, 1), cB + hstepB, voffB); PG8_STAGE(PG8_SA(0, 1), cA + hstepA, voffA);
    if (wr == 1) PG8_BAR;
    PG8_WAIT_V(4); PG8_BAR;
    PG8_STAGE(PG8_SB(1, 0), cB + kstep, voffB); PG8_STAGE(PG8_SA(1, 0), cA + kstep, voffA); PG8_STAGE(PG8_SB(1, 1), cB + hstepB + kstep, voffB);
    PG8_WAIT_V(6); PG8_BAR;
    for (;;) {
        const bool has_next = S.next(ui + 1, nxt);
        const char* nA = has_next ? nxt.A : cA; const char* nB = has_next ? nxt.B : cB;
        for (int t = 0; t < nt; t += 2) {
            const bool last = (t == nt - 2);
            const char* a1 = cA + (size_t)(t + 1) * kstep;
            const char* a2 = last ? nA : cA + (size_t)(t + 2) * kstep; const char* b2 = last ? nB : cB + (size_t)(t + 2) * kstep;
            const char* a3 = a2 + kstep; const char* b3 = b2 + kstep;
            PG8_LDB(B0, 0, 0); PG8_SCHED; PG8_LDA(At, 0, 0); PG8_STAGE(PG8_SA(1, 1), a1 + hstepA, voffA);
            PG8_WAIT_L(8); PG8_BAR; PG8_WAIT_L(0); PG8_MMA(0, 0, At, B0); PG8_BAR; PG8_SCHED;
            PG8_LDB(B1, 0, 1); PG8_STAGE(PG8_SB(0, 0), b2, voffB);
            PG8_BAR; PG8_WAIT_L(0); PG8_MMA(0, 1, At, B1); PG8_BAR;
            PG8_LDA(At, 0, 1); PG8_STAGE(PG8_SA(0, 0), a2, voffA);
            PG8_BAR; PG8_WAIT_L(0); PG8_MMA(1, 0, At, B0); PG8_BAR; PG8_SCHED;
            PG8_STAGE(PG8_SB(0, 1), b2 + hstepB, voffB);
            PG8_WAIT_V(6); PG8_BAR; PG8_MMA(1, 1, At, B1); PG8_BAR;
            PG8_LDB(B0, 1, 0); PG8_SCHED; PG8_LDA(At, 1, 0); PG8_STAGE(PG8_SA(0, 1), a2 + hstepA, voffA);
            PG8_WAIT_L(8); PG8_BAR; PG8_WAIT_L(0); PG8_MMA(0, 0, At, B0); PG8_BAR; PG8_SCHED;
            PG8_LDB(B1, 1, 1); PG8_STAGE(PG8_SB(1, 0), b3, voffB);
            PG8_BAR; PG8_WAIT_L(0); PG8_MMA(0, 1, At, B1); PG8_BAR;
            PG8_LDA(At, 1, 1); PG8_STAGE(PG8_SA(1, 0), a3, voffA);
            PG8_BAR; PG8_WAIT_L(0); PG8_MMA(1, 0, At, B0); PG8_BAR; PG8_SCHED;
            PG8_STAGE(PG8_SB(1, 1), b3 + hstepB, voffB);
            PG8_WAIT_V(6); PG8_BAR; PG8_MMA(1, 1, At, B1); PG8_BAR;
        }
        if (cur.last) { E(acc, cur, wr, wc, fr, fq); }
        if (!has_next) break;
        if (cur.last) { PG8_ZERO(); }
        cur = nxt; cA = nA; cB = nB; ++ui;
    }
    PG8_WAIT_V(0);
    if (wr == 0) PG8_BAR;
    PG8_BAR;
#undef PG8_SA
#undef PG8_SB
#undef PG8_STAGE
#undef PG8_LDA
#undef PG8_LDB
#undef PG8_MMA
#undef PG8_WAIT_V
#undef PG8_WAIT_L
#undef PG8_BAR
#undef PG8_SCHED
#undef PG8_ZERO
}

struct DenseOrder {
    const char* A; const char* B; size_t tA, tB; int nM, nN, nwg, G, c;
    __device__ __forceinline__ void init(const void* A_, const void* B_, int M, int N, unsigned pitchA, unsigned pitchB, int G_, int c_) {
        A = (const char*)A_; B = (const char*)B_; nM = M / BM; nN = N / BM; nwg = nM * nN; G = G_; c = c_; tA = (size_t)BM * pitchA * 2; tB = (size_t)BM * pitchB * 2; }
    __device__ __forceinline__ bool next(int i, Item& it) const {
        const long L = (long)i * G + c; if (L >= nwg) return false;
        int wgid = (int)L; { const int q = nwg / 8, r = nwg % 8, xcd = wgid % 8, off = wgid / 8; wgid = (xcd < r ? xcd * (q + 1) : r * (q + 1) + (xcd - r) * q) + off; }
        const int nig = 8 * nN, gid = wgid / nig, fm = gid * 8, gsz = (nM - fm) < 8 ? (nM - fm) : 8;
        it.pm = fm + ((wgid % nig) % gsz); it.pn = (wgid % nig) / gsz; it.aux = 0; it.first = true; it.last = true;
        it.A = A + (size_t)it.pm * tA; it.B = B + (size_t)it.pn * tB; return true;
    }
};
struct MoeOrder {
    const char* A; const char* B; const LAS int* tstart; size_t eB; int ntiles, npn, G, c; unsigned pitchA;
    __device__ __forceinline__ bool next(int i, Item& it) const {
        int e, j, pn;
        if ((G & 7) == 0) {
            const int x = c & 7, W = G >> 3, U = i * W + (c >> 3);
            int rem = U; e = -1; j = 0; pn = 0;
#pragma unroll
            for (int k = 0; k < 4; ++k) { const int ee = x + 8 * k; const int nt = tstart[ee + 1] - tstart[ee]; const int nu = nt * npn;
                if (e < 0) { if (rem < nu) { e = ee; j = rem % nt; pn = rem / nt; } else rem -= nu; } }
            if (e < 0) return false;
            e = __builtin_amdgcn_readfirstlane(e); j = __builtin_amdgcn_readfirstlane(j); pn = __builtin_amdgcn_readfirstlane(pn);
        } else {
            const long L = (long)i * G + c; if (L >= (long)ntiles * npn) return false;
            const int tile = (int)(L / npn), lane = threadIdx.x & 63; pn = (int)(L % npn);
            bool mine = false; if (lane < 32) { mine = (tstart[lane] <= tile) && (tile < tstart[lane + 1]); }
            const unsigned long long bal = __ballot(mine);
            e = __builtin_amdgcn_readfirstlane((int)__builtin_ctzll(bal | (1ull << 63)));
            j = tile - __builtin_amdgcn_readfirstlane(tstart[e]);
        }
        it.pm = e * (ECAP / BM) + j; it.pn = pn; it.aux = e; it.first = true; it.last = true;
        it.A = A + (size_t)it.pm * BM * pitchA * 2; it.B = B + (size_t)e * eB + (size_t)pn * BM * 1024 * 2; return true;
    }
};
struct RetSOrder {
    const char* Q; const char* Kp; int G, c;
    __device__ __forceinline__ bool next(int i, Item& it) const {
        const int L = i * G + c; if (L >= 256) return false;
        it.pm = L >> 2; it.pn = L & 3; it.aux = 0; it.first = true; it.last = true;
        const size_t off = ((size_t)it.pm * 256 * 1024 + (size_t)it.pn * 256) * 2; it.A = Q + off; it.B = Kp + off; return true;
    }
};
struct RetUOrder {
    const char* VT; const char* KT; int G, c;
    __device__ __forceinline__ bool next(int i, Item& it) const {
        const int L = i * G + c; if (L >= 512) return false;
        const int bh = L >> 5, ch = (L >> 1) & 15, vt = L & 1, b = bh >> 2, h = bh & 3;
        it.pm = L; it.pn = 0; it.aux = 0; it.first = true; it.last = true;
        it.A = VT + (((size_t)b * 2048 + h * 512 + vt * 256) * 4096 + (size_t)ch * 256) * 2;
        it.B = KT + (((size_t)b * 1024 + h * 256) * 4096 + (size_t)ch * 256) * 2; return true;
    }
};
struct RetOOrder {
    const char* Q; const char* SP; const char* RT; const char* VT; int G, c;
    __device__ __forceinline__ bool next(int i, Item& it) const {
        const int L = (i >> 1) * G + c; if (L >= 512) return false;
        const int seg = i & 1, bh = L >> 5, ch = (L >> 1) & 15, vt = L & 1, b = bh >> 2, h = bh & 3;
        it.pm = L; it.pn = 0; it.aux = 0; it.first = (seg == 0); it.last = (seg == 1);
        const size_t aoff = (((size_t)b * 4096 + (size_t)ch * 256) * 1024 + (size_t)h * 256) * 2;
        if (seg == 0) { it.A = Q + aoff; it.B = RT + (((size_t)bh * 512 + vt * 256) * 4096 + (size_t)ch * 256) * 2; }
        else { it.A = SP + aoff; it.B = VT + (((size_t)b * 2048 + h * 512 + vt * 256) * 4096 + (size_t)ch * 256) * 2; }
        return true;
    }
};

typedef f32x4 Acc[2][2][4][2];
struct EpiQKV { static constexpr bool PERM = true; bf16_t* O;
    __device__ __forceinline__ void operator()(const Acc& acc, const Item& u, int wr, int wc, int fr, int fq) const {
        asm volatile("" : "+v"(fr), "+v"(fq));
        const int row0 = u.pm * BM + wr * 64 + fr; const int t = u.pn >> 2; bf16_t* base = O + (size_t)t * T * 1024; const int col0 = (u.pn & 3) * 256 + wc * 32 + 8 * fq;
#pragma unroll
        for (int ai = 0; ai < 2; ++ai)
#pragma unroll
            for (int m = 0; m < 4; ++m) { bf16_t* rowp = base + (size_t)(row0 + ai * HALF + m * 16) * 1024 + col0;
#pragma unroll
                for (int bj = 0; bj < 2; ++bj) { const f32x4 v0 = acc[ai][bj][m][0], v1 = acc[ai][bj][m][1];
                    u32x4 w; w.x = cvt_pk_bf16(v0[0], v0[1]); w.y = cvt_pk_bf16(v0[2], v0[3]); w.z = cvt_pk_bf16(v1[0], v1[1]); w.w = cvt_pk_bf16(v1[2], v1[3]);
                    *(u32x4*)(rowp + bj * HALF) = w; } }
    }
};
struct EpiF32 { static constexpr bool PERM = false; float* C; int ldc;
    __device__ __forceinline__ void operator()(const Acc& acc, const Item& u, int wr, int wc, int fr, int fq) const {
        asm volatile("" : "+v"(fr), "+v"(fq));
        const int row0 = u.pm * BM + wr * 64 + fr, col0 = u.pn * BM + wc * 32 + 4 * fq;
#pragma unroll
        for (int ai = 0; ai < 2; ++ai)
#pragma unroll
            for (int m = 0; m < 4; ++m) { float* rowp = C + (size_t)(row0 + ai * HALF + m * 16) * ldc + col0;
#pragma unroll
                for (int bj = 0; bj < 2; ++bj)
#pragma unroll
                    for (int n = 0; n < 2; ++n) *(f32x4*)(rowp + bj * HALF + n * 16) = acc[ai][bj][m][n]; }
    }
};
struct EpiSwiglu { static constexpr bool PERM = true; bf16_t* O; const float* b1;
    __device__ __forceinline__ void operator()(const Acc& acc, const Item& u, int wr, int wc, int fr, int fq) const {
        asm volatile("" : "+v"(fr), "+v"(fq));
        const int row0 = u.pm * BM + wr * 64 + fr, j0 = u.pn * 128 + wc * 32 + 8 * fq;
        const float* bb = b1 + (size_t)u.aux * 2048 + j0;
        f32x4 bg[2], bl[2];
#pragma unroll
        for (int n = 0; n < 2; ++n) { bg[n] = *(const f32x4*)(bb + 4 * n); bl[n] = *(const f32x4*)(bb + 1024 + 4 * n); }
#pragma unroll
        for (int ai = 0; ai < 2; ++ai)
#pragma unroll
            for (int m = 0; m < 4; ++m) { float o[8];
#pragma unroll
                for (int n = 0; n < 2; ++n)
#pragma unroll
                    for (int i = 0; i < 4; ++i) { float g = acc[ai][0][m][n][i] + bg[n][i], l = acc[ai][1][m][n][i] + bl[n][i];
                        g = fminf(g, 7.0f); l = fminf(fmaxf(l, -7.0f), 7.0f);
                        const float sg = __builtin_amdgcn_rcpf(1.0f + __builtin_amdgcn_exp2f(-1.702f * 1.4426950408889634f * g));
                        o[n * 4 + i] = g * sg * (l + 1.0f); }
                u32x4 w; w.x = cvt_pk_bf16(o[0], o[1]); w.y = cvt_pk_bf16(o[2], o[3]); w.z = cvt_pk_bf16(o[4], o[5]); w.w = cvt_pk_bf16(o[6], o[7]);
                *(u32x4*)(O + (size_t)(row0 + ai * HALF + m * 16) * 1024 + j0) = w; }
    }
};
struct EpiY { static constexpr bool PERM = true; bf16_t* O; const float* b2;
    __device__ __forceinline__ void operator()(const Acc& acc, const Item& u, int wr, int wc, int fr, int fq) const {
        asm volatile("" : "+v"(fr), "+v"(fq));
        const int row0 = u.pm * BM + wr * 64 + fr, col0 = u.pn * BM + wc * 32 + 8 * fq;
        const float* bb = b2 + (size_t)u.aux * 1024 + col0;
        f32x4 bv[2][2];
#pragma unroll
        for (int bj = 0; bj < 2; ++bj)
#pragma unroll
            for (int n = 0; n < 2; ++n) bv[bj][n] = *(const f32x4*)(bb + bj * HALF + 4 * n);
#pragma unroll
        for (int ai = 0; ai < 2; ++ai)
#pragma unroll
            for (int m = 0; m < 4; ++m) { bf16_t* rowp = O + (size_t)(row0 + ai * HALF + m * 16) * 1024 + col0;
#pragma unroll
                for (int bj = 0; bj < 2; ++bj) { const f32x4 v0 = acc[ai][bj][m][0] + bv[bj][0], v1 = acc[ai][bj][m][1] + bv[bj][1];
                    u32x4 w; w.x = cvt_pk_bf16(v0[0], v0[1]); w.y = cvt_pk_bf16(v0[2], v0[3]); w.z = cvt_pk_bf16(v1[0], v1[1]); w.w = cvt_pk_bf16(v1[2], v1[3]);
                    *(u32x4*)(rowp + bj * HALF) = w; } }
    }
};
struct EpiRope { static constexpr bool PERM = true; bf16_t* Qp; bf16_t* Kp; const float* cs; const float* sn;
    __device__ __forceinline__ void operator()(const Acc& acc, const Item& u, int wr, int wc, int fr, int fq) const {
        asm volatile("" : "+v"(fr), "+v"(fq));
        const bool isk = u.pn >= 4; const int h = u.pn & 3; bf16_t* dst = (isk ? Kp : Qp) + (size_t)u.pm * BM * 1024 + h * 256;
        const float lg = gamma_log2(h); const int posb = (u.pm & 15) * 256; const int j0 = wc * 32 + 8 * fq;
#pragma unroll
        for (int ai = 0; ai < 2; ++ai)
#pragma unroll
            for (int m = 0; m < 4; ++m) { const int r = ai * HALF + wr * 64 + m * 16 + fr;
                const float f = isk ? __builtin_amdgcn_exp2f(-(float)r * lg) * 0.0625f : __builtin_amdgcn_exp2f((float)r * lg);
                const float* cp = cs + (size_t)(posb + r) * 128 + j0; const float* sp = sn + (size_t)(posb + r) * 128 + j0;
#pragma unroll
                for (int n = 0; n < 2; ++n) { const f32x4 c4 = *(const f32x4*)(cp + 4 * n), s4 = *(const f32x4*)(sp + 4 * n);
                    const f32x4 t1 = acc[ai][0][m][n], t2 = acc[ai][1][m][n];
                    const f32x4 o1 = (t1 * c4 - t2 * s4) * f, o2 = (t1 * s4 + t2 * c4) * f;
                    u32x2 w1, w2; w1.x = cvt_pk_bf16(o1[0], o1[1]); w1.y = cvt_pk_bf16(o1[2], o1[3]); w2.x = cvt_pk_bf16(o2[0], o2[1]); w2.y = cvt_pk_bf16(o2[2], o2[3]);
                    *(u32x2*)(dst + (size_t)r * 1024 + j0 + 4 * n) = w1; *(u32x2*)(dst + (size_t)r * 1024 + 128 + j0 + 4 * n) = w2; }
                asm volatile("" ::: "memory"); }
    }
};
struct EpiSwap { static constexpr bool PERM = true; bf16_t* VT;
    __device__ __forceinline__ void operator()(const Acc& acc, const Item& u, int wr, int wc, int fr, int fq) const {
        asm volatile("" : "+v"(fr), "+v"(fq));
        const int b = u.pn >> 4, ch = u.pn & 15;
        bf16_t* dst = VT + ((size_t)b * 2048 + (size_t)u.pm * 256) * 4096 + (size_t)ch * 256;
#pragma unroll
        for (int ai = 0; ai < 2; ++ai)
#pragma unroll
            for (int m = 0; m < 4; ++m) { bf16_t* rowp = dst + (size_t)(ai * HALF + wr * 64 + m * 16 + fr) * 4096 + wc * 32 + 8 * fq;
#pragma unroll
                for (int bj = 0; bj < 2; ++bj) { const f32x4 v0 = acc[ai][bj][m][0], v1 = acc[ai][bj][m][1];
                    u32x4 w; w.x = cvt_pk_bf16(v0[0], v0[1]); w.y = cvt_pk_bf16(v0[2], v0[3]); w.z = cvt_pk_bf16(v1[0], v1[1]); w.w = cvt_pk_bf16(v1[2], v1[3]);
                    *(u32x4*)(rowp + bj * HALF) = w; } }
    }
};
struct EpiSilu { static constexpr bool PERM = true; bf16_t* O;
    __device__ __forceinline__ void operator()(const Acc& acc, const Item& u, int wr, int wc, int fr, int fq) const {
        asm volatile("" : "+v"(fr), "+v"(fq));
        const int row0 = u.pm * BM + wr * 64 + fr, col0 = u.pn * BM + wc * 32 + 8 * fq;
#pragma unroll
        for (int ai = 0; ai < 2; ++ai)
#pragma unroll
            for (int m = 0; m < 4; ++m) { bf16_t* rowp = O + (size_t)(row0 + ai * HALF + m * 16) * 2048 + col0;
#pragma unroll
                for (int bj = 0; bj < 2; ++bj) { float o[8];
#pragma unroll
                    for (int n = 0; n < 2; ++n)
#pragma unroll
                        for (int i = 0; i < 4; ++i) { const float g = acc[ai][bj][m][n][i]; o[n * 4 + i] = g * __builtin_amdgcn_rcpf(1.0f + __builtin_amdgcn_exp2f(-1.4426950408889634f * g)); }
                    u32x4 w; w.x = cvt_pk_bf16(o[0], o[1]); w.y = cvt_pk_bf16(o[2], o[3]); w.z = cvt_pk_bf16(o[4], o[5]); w.w = cvt_pk_bf16(o[6], o[7]);
                    *(u32x4*)(rowp + bj * HALF) = w; } }
    }
};
struct EpiSMask { static constexpr bool PERM = true; bf16_t* O;
    __device__ __forceinline__ void operator()(const Acc& acc, const Item& u, int wr, int wc, int fr, int fq) const {
        asm volatile("" : "+v"(fr), "+v"(fq));
        bf16_t* dst = O + (size_t)u.pm * BM * 1024 + u.pn * 256;
        int cb = wc * 32 + 8 * fq; asm volatile("" : "+v"(cb));
#pragma unroll
        for (int ai = 0; ai < 2; ++ai)
#pragma unroll
            for (int m = 0; m < 4; ++m) { int r = ai * HALF + wr * 64 + m * 16 + fr; asm volatile("" : "+v"(r) :: "memory");
#pragma unroll
                for (int bj = 0; bj < 2; ++bj) { const int c0 = bj * HALF + cb; float o[8];
#pragma unroll
                    for (int n = 0; n < 2; ++n)
#pragma unroll
                        for (int i = 0; i < 4; ++i) o[n * 4 + i] = acc[ai][bj][m][n][i] * __builtin_amdgcn_fmed3f((float)(r - c0 - n * 4 - i + 1), 0.f, 1.f);
                    u32x4 w; w.x = cvt_pk_bf16(o[0], o[1]); w.y = cvt_pk_bf16(o[2], o[3]); w.z = cvt_pk_bf16(o[4], o[5]); w.w = cvt_pk_bf16(o[6], o[7]);
                    *(u32x4*)(dst + (size_t)r * 1024 + c0) = w; } }
    }
};
struct EpiUT { static constexpr bool PERM = false; float* C;
    __device__ __forceinline__ void operator()(const Acc& acc, const Item& u, int wr, int wc, int fr, int fq) const {
        asm volatile("" : "+v"(fr), "+v"(fq));
        const int row0 = wr * 64 + fr, col0 = wc * 32 + 4 * fq; float* base = C + (size_t)u.pm * 256 * 256;
#pragma unroll
        for (int ai = 0; ai < 2; ++ai)
#pragma unroll
            for (int m = 0; m < 4; ++m) { float* rowp = base + (size_t)(row0 + ai * HALF + m * 16) * 256 + col0;
#pragma unroll
                for (int bj = 0; bj < 2; ++bj)
#pragma unroll
                    for (int n = 0; n < 2; ++n) *(f32x4*)(rowp + bj * HALF + n * 16) = acc[ai][bj][m][n]; }
    }
};
struct EpiRetO { static constexpr bool PERM = false; float* C;
    __device__ __forceinline__ void operator()(const Acc& acc, const Item& u, int wr, int wc, int fr, int fq) const {
        asm volatile("" : "+v"(fr), "+v"(fq));
        const int L = u.pm, bh = L >> 5, ch = (L >> 1) & 15, vt = L & 1, b = bh >> 2, h = bh & 3;
        float* base = C + ((size_t)b * 4096 + (size_t)ch * 256) * 2048 + h * 512 + vt * 256; const int row0 = wr * 64 + fr, col0 = wc * 32 + 4 * fq;
#pragma unroll
        for (int ai = 0; ai < 2; ++ai)
#pragma unroll
            for (int m = 0; m < 4; ++m) { float* rowp = base + (size_t)(row0 + ai * HALF + m * 16) * 2048 + col0;
#pragma unroll
                for (int bj = 0; bj < 2; ++bj)
#pragma unroll
                    for (int n = 0; n < 2; ++n) *(f32x4*)(rowp + bj * HALF + n * 16) = acc[ai][bj][m][n]; }
    }
};
}

namespace att {
constexpr int D = 128, PITCH = 1024, NW = 8, QBLK = 32, KVBLK = 64, QB = 256;
constexpr float SCALE = 0.08838834764831845f;
constexpr float THR = 8.f;
constexpr int SHM_V = KVBLK * D * 2, SHM_K = KVBLK * D * 2;
constexpr int LDS_BYTES = 2 * SHM_V + 2 * SHM_K + NW * 64 * 4;
constexpr int LDS_CS = LDS_BYTES;
#define KSWZ(row, colB) ((row) * 256 + ((colB) ^ (((row) & 7) << 4)))
#define SBAR() __builtin_amdgcn_sched_barrier(0)
__device__ __forceinline__ int v_st(int k, int c) { const int kk = (k & ~0xC) | ((k & 4) << 1) | ((k & 8) >> 1); return ((kk >> 3) * 4 + (c >> 5)) * 512 + ((kk & 7) * 32 + (c & 31)) * 2; }
__device__ __forceinline__ int v_rd_base(int lane) { return ((lane & 3) << 3) | (((lane >> 2) & 3) << 6) | (((lane >> 4) & 1) << 5) | (((lane >> 5) & 1) << 8); }
constexpr int v_rd_off(int d0, int ks, int half) { return d0 * 512 + ks * 4096 + half * 2048; }
__device__ __forceinline__ int crow(int r, int hi) { return (r & 3) + 8 * (r >> 2) + 4 * hi; }
__device__ __forceinline__ unsigned cvtpk(float lo, float hi) { unsigned r; asm volatile("v_cvt_pk_bf16_f32 %0, %1, %2" : "=v"(r) : "v"(lo), "v"(hi)); return r; }
__device__ __forceinline__ void mask_tile(f32x16& p0, f32x16& p1, int dq) {
    const float NEG = -__builtin_inff();
#pragma unroll
    for (int r = 0; r < 16; ++r) { const int c = (r & 3) + 8 * (r >> 2);
        if (dq - c < 0) p0[r] = NEG;
        if (dq - c - 32 < 0) p1[r] = NEG; }
}
__device__ __forceinline__ void partialSM(f32x16& p0, f32x16& p1, float& m_reg, float& alpha, const float cq) {
    float pmax = p0[0];
#pragma unroll
    for (int r = 1; r < 16; ++r) pmax = fmaxf(pmax, p0[r]);
#pragma unroll
    for (int r = 0; r < 16; ++r) pmax = fmaxf(pmax, p1[r]);
    { auto rr = __builtin_amdgcn_permlane32_swap(__float_as_uint(pmax), __float_as_uint(pmax), false, false);
      pmax = fmaxf(__uint_as_float(rr[0]), __uint_as_float(rr[1])); }
    pmax += cq;
    constexpr float C2 = 1.4426950408889634f * SCALE;
    float mn;
    if (__builtin_expect(__all((pmax - m_reg) * SCALE <= THR), 1)) { mn = m_reg; alpha = 1.f; }
    else { mn = fmaxf(m_reg, pmax); alpha = __builtin_amdgcn_exp2f((m_reg - mn) * C2); m_reg = mn; }
    const float mnL = (cq - mn) * C2;
#pragma unroll
    for (int r = 0; r < 16; ++r) p0[r] = fmaf(p0[r], C2, mnL);
#pragma unroll
    for (int r = 0; r < 16; ++r) p1[r] = fmaf(p1[r], C2, mnL);
}
__device__ __forceinline__ void finishSM(f32x16& p0, f32x16& p1, float alpha, float& l_reg, bf16x8& pa0, bf16x8& pa1, bf16x8& pa2, bf16x8& pa3) {
#pragma unroll
    for (int r = 0; r < 16; ++r) p0[r] = __builtin_amdgcn_exp2f(p0[r]);
#pragma unroll
    for (int r = 0; r < 16; ++r) p1[r] = __builtin_amdgcn_exp2f(p1[r]);
    float ps = 0;
#pragma unroll
    for (int r = 0; r < 16; ++r) ps += p0[r];
#pragma unroll
    for (int r = 0; r < 16; ++r) ps += p1[r];
    { auto rr = __builtin_amdgcn_permlane32_swap(__float_as_uint(ps), __float_as_uint(ps), false, false);
      ps = __uint_as_float(rr[0]) + __uint_as_float(rr[1]); }
    l_reg = l_reg * alpha + ps;
#define PK4(P, B_, OUT) do { unsigned a0 = cvtpk(P[B_+0], P[B_+1]), a1 = cvtpk(P[B_+2], P[B_+3]);                          \
        unsigned b0 = cvtpk(P[B_+4], P[B_+5]), b1 = cvtpk(P[B_+6], P[B_+7]);                                             \
        auto r0 = __builtin_amdgcn_permlane32_swap(a0, b0, false, false); auto r1 = __builtin_amdgcn_permlane32_swap(a1, b1, false, false); \
        u32x4 w = {r0[0], r1[0], r0[1], r1[1]}; OUT = *reinterpret_cast<bf16x8*>(&w); } while (0)
    PK4(p0, 0, pa0); PK4(p0, 8, pa1); PK4(p1, 0, pa2); PK4(p1, 8, pa3);
#undef PK4
}
template <int KB, int MODE>
__device__ __forceinline__ void qkt(f32x16& p0, f32x16& p1, const char* K_lds, const float* init, int r32, int hi, const bf16x8* qr) {
    if (MODE == 0) {
#pragma unroll
        for (int g = 0; g < 4; ++g) { const f32x4 a = *(const f32x4*)(init + 8 * g), b = *(const f32x4*)(init + 32 + 8 * g);
#pragma unroll
            for (int i = 0; i < 4; ++i) { p0[4 * g + i] = a[i]; p1[4 * g + i] = b[i]; } }
    } else { p0 = f32x16{}; p1 = f32x16{}; }
    const char* kb[4];
#pragma unroll
    for (int dd = 0; dd < 4; ++dd) kb[dd] = K_lds + KB * SHM_K + KSWZ(r32, (dd * 16 + hi * 8) * 2);
#pragma unroll
    for (int d0 = 0; d0 < 8; ++d0) { const char* a = kb[d0 & 3] + (d0 >> 2) * 128;
        bf16x8 b0 = *reinterpret_cast<const bf16x8*>(a);
        bf16x8 b1 = *reinterpret_cast<const bf16x8*>(a + 32 * 256);
        p0 = __builtin_amdgcn_mfma_f32_32x32x16_bf16(b0, qr[d0], p0, 0, 0, 0);
        p1 = __builtin_amdgcn_mfma_f32_32x32x16_bf16(b1, qr[d0], p1, 0, 0, 0); }
}
template <int VB>
__device__ __forceinline__ void pv_tile(f32x16* o, int vb0, bf16x8 pa0, bf16x8 pa1, bf16x8 pa2, bf16x8 pa3) {
#define TRRD(dst, off) asm volatile("ds_read_b64_tr_b16 %0, %1 offset:%2" : "=&v"(dst) : "v"(vb0), "i"(off) : "memory")
#define PV_D0(d0) do { s16x4 l0, l1, l2, l3, h0, h1, h2, h3; constexpr int b_ = VB * SHM_V + v_rd_off(d0, 0, 0); \
        TRRD(l0, b_); TRRD(h0, b_ + 2048); TRRD(l1, b_ + 4096); TRRD(h1, b_ + 6144); TRRD(l2, b_ + 8192); TRRD(h2, b_ + 10240); TRRD(l3, b_ + 12288); TRRD(h3, b_ + 14336); \
        asm volatile("s_waitcnt lgkmcnt(0)" ::: "memory"); SBAR();   \
        o[d0] = __builtin_amdgcn_mfma_f32_32x32x16_bf16(pa0, (bf16x8){l0[0], l0[1], l0[2], l0[3], h0[0], h0[1], h0[2], h0[3]}, o[d0], 0, 0, 0);   \
        o[d0] = __builtin_amdgcn_mfma_f32_32x32x16_bf16(pa1, (bf16x8){l1[0], l1[1], l1[2], l1[3], h1[0], h1[1], h1[2], h1[3]}, o[d0], 0, 0, 0);   \
        o[d0] = __builtin_amdgcn_mfma_f32_32x32x16_bf16(pa2, (bf16x8){l2[0], l2[1], l2[2], l2[3], h2[0], h2[1], h2[2], h2[3]}, o[d0], 0, 0, 0);   \
        o[d0] = __builtin_amdgcn_mfma_f32_32x32x16_bf16(pa3, (bf16x8){l3[0], l3[1], l3[2], l3[3], h3[0], h3[1], h3[2], h3[3]}, o[d0], 0, 0, 0); } while (0)
    PV_D0(0); PV_D0(1); PV_D0(2); PV_D0(3);
#undef PV_D0
#undef TRRD
}
struct BlockRef { const bf16_t* Q; const bf16_t* K; const bf16_t* V; bf16_t* O; int P0; };
#define ROW(p, k0, rr) ((p) + (size_t)((k0) + (rr)) * PITCH + sc)
#define VMW() asm volatile("s_waitcnt vmcnt(0)" ::: "memory")
#define LD8(p) (*reinterpret_cast<const bf16x8*>(p))
#define SLOAD_H(Kp, Vp, k0) do { st_v0 = LD8(ROW(Vp, k0, sr)); st_v1 = LD8(ROW(Vp, k0, 32 + sr)); st_k0 = LD8(ROW(Kp, k0, sr)); st_k1 = LD8(ROW(Kp, k0, 32 + sr)); } while (0)
#define SWRITE_H(bf) do { *(bf16x8*)(V_lds + (bf) * SHM_V + vst0) = st_v0; *(bf16x8*)(V_lds + (bf) * SHM_V + vst1) = st_v1; \
                          *(bf16x8*)(K_lds + (bf) * SHM_K + kws) = st_k0; *(bf16x8*)(K_lds + (bf) * SHM_K + kws + 32 * 256) = st_k1; } while (0)
template <int MODE>
__device__ __forceinline__ void attn_block(const BlockRef& cur, const int NT, const unsigned long long list, char* lds, const unsigned selbits) {
    int tid = threadIdx.x; asm volatile("" : "+v"(tid));
    const int wid = __builtin_amdgcn_readfirstlane(tid >> 6), lane = tid & 63, r32 = lane & 31, hi = lane >> 5;
    const int qlo = cur.P0 + wid * QBLK, qm = qlo + r32 - 4 * hi;
    char* V_lds = lds; char* K_lds = lds + 2 * SHM_V;
    float* ws = (float*)(lds + 2 * SHM_V + 2 * SHM_K) + wid * 64; float* li_l = ws, * al_l = ws + 32;
    const float* ncs = (const float*)(lds + LDS_CS);
    float m_reg = -1e30f, l_reg = 0; f32x16 o[4] = {};
    const int sr = tid >> 4, sc = (tid & 15) * 8, vst0 = v_st(sr, sc), vst1 = v_st(32 + sr, sc), kws = KSWZ(sr, sc * 2);
    const int vb0 = (int)(uintptr_t)V_lds + v_rd_base(lane);
    const bf16_t* Kh = cur.K; const bf16_t* Vh = cur.V;
    float cq = 0.f; if (MODE == 0) cq = -ncs[qlo + r32];
#define RESC(a) do { if (__any((a) < 1.f)) { if (hi == 0) al_l[r32] = (a); asm volatile("s_waitcnt lgkmcnt(0)" ::: "memory");              \
                     _Pragma("unroll") for (int d_ = 0; d_ < 4; ++d_) _Pragma("unroll") for (int r = 0; r < 16; ++r) o[d_][r] *= al_l[crow(r, hi)]; } } while (0)
#define KBASE(t) (MODE == 0 ? (NT - 1 - (t)) * KVBLK : (int)((list >> (4 * ((t) >> 2))) & 15ull) * 256 + (3 - ((t) & 3)) * KVBLK)
#define PREP(P0_, P1_, t, kb_) do { \
        if (MODE == 0) { if (kb_ + KVBLK - 1 > qlo) mask_tile(P0_, P1_, qm - kb_); } \
        else { if ((t) < 4) { if (kb_ + KVBLK - 1 > qlo) mask_tile(P0_, P1_, qm - kb_); } \
               else { const bool keep_ = (selbits >> (kb_ >> 8)) & 1u; const float NEG_ = -__builtin_inff(); \
                   _Pragma("unroll") for (int r_ = 0; r_ < 16; ++r_) { P0_[r_] = keep_ ? P0_[r_] : NEG_; P1_[r_] = keep_ ? P1_[r_] : NEG_; } } } } while (0)
    bf16x8 qr[8], st_v0, st_v1, st_k0, st_k1;
#pragma unroll
    for (int d0 = 0; d0 < 8; ++d0) qr[d0] = LD8(cur.Q + (size_t)(wid * QBLK + r32) * PITCH + d0 * 16 + hi * 8);
    SLOAD_H(Kh, Vh, KBASE(0)); VMW(); SWRITE_H(0);
    __syncthreads();
    f32x16 P0, P1; float al; bf16x8 pa0, pa1, pa2, pa3;
#define STEP(t, BUF) do { const int kbt_ = KBASE(t); \
        if ((t) + 1 < NT) { SLOAD_H(Kh, Vh, KBASE((t) + 1)); } SBAR(); \
        qkt<BUF, MODE>(P0, P1, K_lds, ncs + kbt_ + 4 * hi, r32, hi, qr); \
        PREP(P0, P1, t, kbt_); partialSM(P0, P1, m_reg, al, cq); RESC(al); finishSM(P0, P1, al, l_reg, pa0, pa1, pa2, pa3); SBAR(); \
        pv_tile<BUF>(o, vb0, pa0, pa1, pa2, pa3); \
        if ((t) + 1 < NT) { VMW(); SWRITE_H(1 - BUF); } \
        __syncthreads(); } while (0)
    for (int t = 0; t < NT; t += 2) { STEP(t, 0); STEP(t + 1, 1); }
    if (hi == 0) li_l[r32] = l_reg; asm volatile("s_waitcnt lgkmcnt(0)" ::: "memory");
    float rli[16];
#pragma unroll
    for (int r = 0; r < 16; ++r) rli[r] = __builtin_amdgcn_rcpf(li_l[crow(r, hi)]);
    bf16_t* Ow = cur.O + (size_t)(wid * QBLK) * PITCH;
#pragma unroll
    for (int r = 0; r < 16; ++r) { const int orow = crow(r, hi);
#pragma unroll
        for (int d0 = 0; d0 < 4; ++d0) { const float v = o[d0][r] * rli[r];
            const float vn = __shfl_xor(v, 1);
            if ((r32 & 1) == 0) *(unsigned*)(Ow + (size_t)orow * PITCH + d0 * 32 + r32) = cvtpk(v, vn); } }
    __syncthreads();
#undef RESC
#undef KBASE
#undef PREP
#undef STEP
}
#undef ROW
#undef VMW
#undef LD8
#undef SLOAD_H
#undef SWRITE_H
#undef KSWZ
#undef SBAR
}

struct Ctx {
    unsigned char* lds_g;
    LAS unsigned char* lds;
    unsigned char* ws; int tid, lane, wave, G, vcu;
};
#define WSP(T_, off) ((T_*)(C.ws + (off)))

__device__ __forceinline__ void cvt_item(const float* W, size_t ldw, int k0, int n0, bf16_t* WT, size_t Kd, int drow0, LAS unsigned* scr, int lane) {
    const float* src = W + (size_t)k0 * ldw + n0 + lane;
#pragma unroll
    for (int b = 0; b < 4; ++b) { float a[8], c[8];
#pragma unroll
        for (int i = 0; i < 8; ++i) { a[i] = src[(size_t)(2 * (b * 8 + i)) * ldw]; c[i] = src[(size_t)(2 * (b * 8 + i) + 1) * ldw]; }
#pragma unroll
        for (int i = 0; i < 8; ++i) scr[(b * 8 + i) * 65 + lane] = cvt_pk_bf16(a[i], c[i]); }
    LDS_WAIT(); asm volatile("" ::: "memory");
    const int ch = lane & 7;
#pragma unroll
    for (int p = 0; p < 8; ++p) { const int n = p * 8 + (lane >> 3); const LAS unsigned* s = scr + (4 * ch) * 65 + n;
        u32x4 w; w.x = s[0]; w.y = s[65]; w.z = s[130]; w.w = s[195];
        *(u32x4*)(WT + (size_t)(drow0 + n) * Kd + k0 + 8 * ch) = w; }
    LDS_WAIT(); asm volatile("" ::: "memory");
}
__device__ __forceinline__ float log_sigmoid(float z) { return fminf(z, 0.f) - log1pf(__expf(-fabsf(z))); }
__device__ __forceinline__ void fox_gate_row(const f32x4 (&xn)[4], const LAS float* fgT, const float* b_f, float* logf, int tok, int lane) {
    float p[8];
#pragma unroll
    for (int h = 0; h < 8; ++h) { float s = 0.f;
#pragma unroll
        for (int j = 0; j < 4; ++j) { const f32x4 w = *(const LAS f32x4*)(fgT + h * 1024 + lane * 4 + 256 * j); s += xn[j][0] * w[0] + xn[j][1] * w[1] + xn[j][2] * w[2] + xn[j][3] * w[3]; }
        p[h] = s; }
    const bool u5 = lane & 32, u4 = lane & 16, u3 = lane & 8;
    float q4[4], q2[2], q1;
#pragma unroll
    for (int i = 0; i < 4; ++i) { const float keep = u5 ? p[i + 4] : p[i], give = u5 ? p[i] : p[i + 4]; q4[i] = keep + __shfl_xor(give, 32); }
#pragma unroll
    for (int i = 0; i < 2; ++i) { const float keep = u4 ? q4[i + 2] : q4[i], give = u4 ? q4[i] : q4[i + 2]; q2[i] = keep + __shfl_xor(give, 16); }
    { const float keep = u3 ? q2[1] : q2[0], give = u3 ? q2[0] : q2[1]; q1 = keep + __shfl_xor(give, 8); }
    q1 += __shfl_xor(q1, 4); q1 += __shfl_xor(q1, 2); q1 += __shfl_xor(q1, 1);
    const int h = lane >> 3;
    if ((lane & 7) == 0) { const int b = tok >> 12, s = tok & 4095; logf[((size_t)b * 8 + h) * SEQ + s] = log_sigmoid(q1 + b_f[h]); }
}
__device__ __forceinline__ void stage_fgT(const Ctx& C, const float* w_in, LAS float* fgT) {
    for (int k = C.tid; k < 1024; k += NTHREADS) { const f32x4 a = *(const f32x4*)(w_in + (size_t)k * 3080 + 3072), b = *(const f32x4*)(w_in + (size_t)k * 3080 + 3076);
        fgT[0 * 1024 + k] = a[0]; fgT[1 * 1024 + k] = a[1]; fgT[2 * 1024 + k] = a[2]; fgT[3 * 1024 + k] = a[3];
        fgT[4 * 1024 + k] = b[0]; fgT[5 * 1024 + k] = b[1]; fgT[6 * 1024 + k] = b[2]; fgT[7 * 1024 + k] = b[3]; }
    LDS_WAIT(); __syncthreads();
}
__device__ __forceinline__ void phase_prologue(const Ctx& C, const float* const* in) {
    LAS unsigned* scr = (LAS unsigned*)(C.lds + C.wave * 8320);
    const int gw = C.vcu * NWAVES + C.wave, NGW = C.G * NWAVES;
    constexpr int I_FI = 16 * 48, I_FO = 16 * 16, I_RI = 16 * 96, I_RO = 32 * 16, I_W1 = 16 * 32, I_W2 = 16 * 16;
    constexpr int R0 = 2 * I_FI, R1 = R0 + 2 * I_FO, R2 = R1 + I_FI, R3 = R2 + I_FO, R4 = R3 + I_RI, R5 = R4 + I_RO, R6 = R5 + 128 * I_W1, R7 = R6 + 128 * I_W2;
    for (int it = gw; it < R7; it += NGW) {
        int r = it;
        if (r < R0) { const int j = r / I_FI; r -= j * I_FI; const int kb = r / 48, nb = r % 48;
            cvt_item(in[1] + (size_t)j * 1024 * 3080, 3080, kb * 64, nb * 64, WSP(bf16_t, WS_WFOXI) + (size_t)j * 3072 * 1024, 1024, nb * 64, scr, C.lane); continue; }
        if (r < R1) { r -= R0; const int j = r / I_FO; r -= j * I_FO; const int kb = r / 16, nb = r % 16;
            cvt_item(in[3] + (size_t)j * 1024 * 1024, 1024, kb * 64, nb * 64, WSP(bf16_t, WS_WFOXO) + (size_t)j * 1024 * 1024, 1024, nb * 64, scr, C.lane); continue; }
        if (r < R2) { r -= R1; const int kb = r / 48, nb = r % 48;
            cvt_item(in[4], 3072, kb * 64, nb * 64, WSP(bf16_t, WS_WMOBI), 1024, nb * 64, scr, C.lane); continue; }
        if (r < R3) { r -= R2; const int kb = r / 16, nb = r % 16;
            cvt_item(in[5], 1024, kb * 64, nb * 64, WSP(bf16_t, WS_WMOBO), 1024, nb * 64, scr, C.lane); continue; }
        if (r < R4) { r -= R3; const int kb = r / 96, nb = r % 96;
            cvt_item(in[6], 6144, kb * 64, nb * 64, WSP(bf16_t, WS_WRETI), 1024, nb * 64, scr, C.lane); continue; }
        if (r < R5) { r -= R4; const int kb = r / 16, nb = r % 16;
            cvt_item(in[8], 1024, kb * 64, nb * 64, WSP(bf16_t, WS_WRETO), 2048, nb * 64, scr, C.lane); continue; }
        if (r < R6) { r -= R5; const int le = r / I_W1; r -= le * I_W1; const int kb = r / 32, nb = r % 32; const int n0 = nb * 64;
            const int drow = (n0 < 1024) ? ((n0 >> 7) * 256 + (n0 & 127)) : ((((n0 - 1024) >> 7) * 256) + 128 + ((n0 - 1024) & 127));
            cvt_item(in[13] + (size_t)le * 1024 * 2048, 2048, kb * 64, n0, WSP(bf16_t, WS_W1T) + (size_t)le * 2048 * 1024, 1024, drow, scr, C.lane); continue; }
        { r -= R6; const int le = r / I_W2; r -= le * I_W2; const int kb = r / 16, nb = r % 16;
            cvt_item(in[15] + (size_t)le * 1024 * 1024, 1024, kb * 64, nb * 64, WSP(bf16_t, WS_W2T) + (size_t)le * 1024 * 1024, 1024, nb * 64, scr, C.lane); }
    }
    { float* cs = WSP(float, WS_TAB); float* sn = cs + 4096 * 128; float* csT = sn + 4096 * 128; float* snT = csT + 4096 * 128;
      for (int e = C.vcu * NTHREADS + C.tid; e < 4096 * 128; e += C.G * NTHREADS) { const int pos = e >> 7, j = e & 127;
          const float invf = expf(-9.210340371976184f * (float)(2 * j) / 256.0f); const float ang = (float)pos * invf;
          const float c = cosf(ang), s = sinf(ang); cs[e] = c; sn[e] = s; csT[(size_t)j * 4096 + pos] = c; snT[(size_t)j * 4096 + pos] = s; } }
    __syncthreads();
    LAS float* fgT = (LAS float*)C.lds;
    stage_fgT(C, in[1], fgT);
    for (int tok = gw; tok < T; tok += NGW) {
        const f32x4* xr = (const f32x4*)(in[0] + (size_t)tok * DM) + C.lane; f32x4 v[4];
#pragma unroll
        for (int j = 0; j < 4; ++j) v[j] = xr[64 * j];
        f32x4* xo = WSP(f32x4, WS_X) + (size_t)tok * (DM / 4) + C.lane; u32x2* xb = WSP(u32x2, WS_XB) + (size_t)tok * (DM / 4) + C.lane;
#pragma unroll
        for (int j = 0; j < 4; ++j) { xo[64 * j] = v[j]; u32x2 w; w.x = cvt_pk_bf16(v[j][0], v[j][1]); w.y = cvt_pk_bf16(v[j][2], v[j][3]); xb[64 * j] = w; }
        fox_gate_row(v, fgT, in[2], WSP(float, WS_MISC + MS_LOGF), tok, C.lane);
    }
}

__device__ __forceinline__ void phase_ln1_router(const Ctx& C, int li, const float* const* in) {
    LAS float* rwT = (LAS float*)C.lds;
    LAS int* cnt_l = (LAS int*)(C.lds + MISC_OFF + LM_CNT); LAS int* base_l = (LAS int*)(C.lds + MISC_OFF + LM_BASE);
    LAS int* te = (LAS int*)(C.lds + MISC_OFF + LM_TE); LAS int* tlp = (LAS int*)(C.lds + MISC_OFF + LM_TLP); LAS float* tg = (LAS float*)(C.lds + MISC_OFF + LM_TG);
    const float* rw = in[11] + (size_t)li * 1024 * 32; const float* rb = in[12] + li * 32;
    const float* g = in[9] + (size_t)(li * 2 + 0) * DM; const float* bt = in[10] + (size_t)(li * 2 + 0) * DM;
    unsigned* cnt_g = WSP(unsigned, WS_CTL) + CW_CNT + li * 32;
    for (int k = C.tid; k < 1024; k += NTHREADS) {
#pragma unroll
        for (int q = 0; q < 8; ++q) { const f32x4 a = *(const f32x4*)(rw + (size_t)k * 32 + 4 * q);
            rwT[(4 * q + 0) * 1024 + k] = a[0]; rwT[(4 * q + 1) * 1024 + k] = a[1]; rwT[(4 * q + 2) * 1024 + k] = a[2]; rwT[(4 * q + 3) * 1024 + k] = a[3]; } }
    f32x4 gv[4], bv[4];
#pragma unroll
    for (int j = 0; j < 4; ++j) { gv[j] = *((const f32x4*)g + C.lane + 64 * j); bv[j] = *((const f32x4*)bt + C.lane + 64 * j); }
    const float rbias = rb[C.lane >> 1];
    float* X = WSP(float, WS_X); const float* H = WSP(float, WS_H);
    for (int batch = C.vcu; batch < T / 64; batch += C.G) {
        if (C.tid < 32) cnt_l[C.tid] = 0;
        LDS_WAIT(); __syncthreads();
        for (int q = 0; q < 8; ++q) {
            const int tl = C.wave * 8 + q, tok = batch * 64 + tl;
            f32x4* xr = (f32x4*)(X + (size_t)tok * DM) + C.lane; const f32x4* hr = (const f32x4*)(H + (size_t)tok * DM) + C.lane;
            f32x4 v[4]; float s = 0.f;
#pragma unroll
            for (int j = 0; j < 4; ++j) { v[j] = xr[64 * j] * DN_ALPHA + hr[64 * j]; s += (v[j][0] + v[j][1]) + (v[j][2] + v[j][3]); }
            const float mean = wave_sum(s) * (1.f / DM); float s2 = 0.f;
#pragma unroll
            for (int j = 0; j < 4; ++j) { v[j] = v[j] - mean; s2 += (v[j][0] * v[j][0] + v[j][1] * v[j][1]) + (v[j][2] * v[j][2] + v[j][3] * v[j][3]); }
            const float rstd = 1.0f / sqrtf(wave_sum(s2) * (1.f / DM) + LN_EPS);
#pragma unroll
            for (int j = 0; j < 4; ++j) { v[j] = v[j] * rstd * gv[j] + bv[j]; xr[64 * j] = v[j]; }
            float p[32];
#pragma unroll
            for (int e = 0; e < 32; ++e) { float a = 0.f;
#pragma unroll
                for (int j = 0; j < 4; ++j) { const f32x4 w = *(const LAS f32x4*)(rwT + e * 1024 + C.lane * 4 + 256 * j); a += v[j][0] * w[0] + v[j][1] * w[1] + v[j][2] * w[2] + v[j][3] * w[3]; }
                p[e] = a; }
            const bool u5 = C.lane & 32, u4 = C.lane & 16, u3 = C.lane & 8, u2 = C.lane & 4, u1 = C.lane & 2;
            float q16[16], q8[8], q4[4], q2[2], lg;
#pragma unroll
            for (int i = 0; i < 16; ++i) { const float keep = u5 ? p[i + 16] : p[i], give = u5 ? p[i] : p[i + 16]; q16[i] = keep + __shfl_xor(give, 32); }
#pragma unroll
            for (int i = 0; i < 8; ++i) { const float keep = u4 ? q16[i + 8] : q16[i], give = u4 ? q16[i] : q16[i + 8]; q8[i] = keep + __shfl_xor(give, 16); }
#pragma unroll
            for (int i = 0; i < 4; ++i) { const float keep = u3 ? q8[i + 4] : q8[i], give = u3 ? q8[i] : q8[i + 4]; q4[i] = keep + __shfl_xor(give, 8); }
#pragma unroll
            for (int i = 0; i < 2; ++i) { const float keep = u2 ? q4[i + 2] : q4[i], give = u2 ? q4[i] : q4[i + 2]; q2[i] = keep + __shfl_xor(give, 4); }
            { const float keep = u1 ? q2[1] : q2[0], give = u1 ? q2[0] : q2[1]; lg = keep + __shfl_xor(give, 2); }
            lg += __shfl_xor(lg, 1);
            float val = (C.lane & 1) ? -__builtin_inff() : (lg + rbias);
            float tv[4]; int tix[4];
#pragma unroll
            for (int k = 0; k < 4; ++k) { const float m = wave_max(val); const unsigned long long bal = __ballot(val == m); const int ln = (int)__builtin_ctzll(bal);
                tv[k] = m; tix[k] = ln >> 1; if (C.lane == ln) val = -__builtin_inff(); }
            const float e1 = __expf(tv[1] - tv[0]), e2 = __expf(tv[2] - tv[0]), e3 = __expf(tv[3] - tv[0]); const float inv = 1.0f / (1.0f + e1 + e2 + e3);
            if (C.lane < 4) { const int e = C.lane == 0 ? tix[0] : C.lane == 1 ? tix[1] : C.lane == 2 ? tix[2] : tix[3];
                const float gt = (C.lane == 0 ? 1.0f : C.lane == 1 ? e1 : C.lane == 2 ? e2 : e3) * inv;
                const int lp = atomicAdd((int*)(cnt_l + e), 1);
                te[tl * 4 + C.lane] = e; tlp[tl * 4 + C.lane] = lp; tg[tl * 4 + C.lane] = gt; }
        }
        VM_WAIT(); LDS_WAIT(); __syncthreads();
        if (C.tid < 32) { const int n = cnt_l[C.tid]; base_l[C.tid] = n ? (int)__hip_atomic_fetch_add(cnt_g + C.tid, (unsigned)n, __ATOMIC_RELAXED, __HIP_MEMORY_SCOPE_AGENT) : 0; }
        __builtin_amdgcn_fence(__ATOMIC_ACQUIRE, "agent");
        VM_WAIT(); LDS_WAIT(); __syncthreads();
        int* tok_e = WSP(int, WS_MISC + MS_TOKE); int* tok_p = WSP(int, WS_MISC + MS_TOKP); float* tok_g = WSP(float, WS_MISC + MS_TOKG);
        for (int q = 0; q < 8; ++q) {
            const int tl = C.wave * 8 + q, tok = batch * 64 + tl;
            const f32x4* xr = (const f32x4*)(X + (size_t)tok * DM) + C.lane * 4;
            const f32x4 a = xr[0], b = xr[1], c = xr[2], d = xr[3];
            u32x4 w0, w1; w0.x = cvt_pk_bf16(a[0], a[1]); w0.y = cvt_pk_bf16(a[2], a[3]); w0.z = cvt_pk_bf16(b[0], b[1]); w0.w = cvt_pk_bf16(b[2], b[3]);
            w1.x = cvt_pk_bf16(c[0], c[1]); w1.y = cvt_pk_bf16(c[2], c[3]); w1.z = cvt_pk_bf16(d[0], d[1]); w1.w = cvt_pk_bf16(d[2], d[3]);
#pragma unroll
            for (int k = 0; k < 4; ++k) { const int e = te[tl * 4 + k]; const int pos = base_l[e] + tlp[tl * 4 + k];
                u32x4* dst = (u32x4*)(WSP(bf16_t, WS_XS) + ((size_t)e * ECAP + pos) * DM) + C.lane * 2; dst[0] = w0; dst[1] = w1;
                if (C.lane == k) { tok_e[tok * 4 + k] = e; tok_p[tok * 4 + k] = pos; tok_g[tok * 4 + k] = tg[tl * 4 + k]; } }
        }
        LDS_WAIT(); __syncthreads();
    }
}

__device__ __forceinline__ void phase_ln2(const Ctx& C, int li, const float* const* in, float* out, bool do_gate, const float* fox_w_in, const float* fox_b_f) {
    const float* g = in[9] + (size_t)(li * 2 + 1) * DM; const float* bt = in[10] + (size_t)(li * 2 + 1) * DM;
    LAS float* fgT = (LAS float*)C.lds;
    if (do_gate) stage_fgT(C, fox_w_in, fgT);
    f32x4 gv[4], bv[4];
#pragma unroll
    for (int j = 0; j < 4; ++j) { gv[j] = *((const f32x4*)g + C.lane + 64 * j); bv[j] = *((const f32x4*)bt + C.lane + 64 * j); }
    const int gw = C.vcu * NWAVES + C.wave, NGW = C.G * NWAVES;
    const int* tok_e = WSP(int, WS_MISC + MS_TOKE); const int* tok_p = WSP(int, WS_MISC + MS_TOKP); const float* tok_g = WSP(float, WS_MISC + MS_TOKG);
    float* X = WSP(float, WS_X); const bf16_t* Y = WSP(bf16_t, WS_XS);
    for (int tok = gw; tok < T; tok += NGW) {
        f32x4* xr = (f32x4*)(X + (size_t)tok * DM) + C.lane;
        int ek[4], pk[4]; float gk[4];
#pragma unroll
        for (int k = 0; k < 4; ++k) { ek[k] = tok_e[tok * 4 + k]; pk[k] = tok_p[tok * 4 + k]; gk[k] = tok_g[tok * 4 + k]; }
        f32x4 v[4];
#pragma unroll
        for (int j = 0; j < 4; ++j) v[j] = xr[64 * j] * DN_ALPHA;
#pragma unroll
        for (int k = 0; k < 4; ++k) { const u32x2* yr = (const u32x2*)(Y + ((size_t)ek[k] * ECAP + pk[k]) * DM) + C.lane;
#pragma unroll
            for (int j = 0; j < 4; ++j) { const u32x2 w = yr[64 * j]; v[j][0] += gk[k] * bflo(w.x); v[j][1] += gk[k] * bfhi(w.x); v[j][2] += gk[k] * bflo(w.y); v[j][3] += gk[k] * bfhi(w.y); } }
        float s = 0.f;
#pragma unroll
        for (int j = 0; j < 4; ++j) s += (v[j][0] + v[j][1]) + (v[j][2] + v[j][3]);
        const float mean = wave_sum(s) * (1.f / DM); float s2 = 0.f;
#pragma unroll
        for (int j = 0; j < 4; ++j) { v[j] = v[j] - mean; s2 += (v[j][0] * v[j][0] + v[j][1] * v[j][1]) + (v[j][2] * v[j][2] + v[j][3] * v[j][3]); }
        const float rstd = 1.0f / sqrtf(wave_sum(s2) * (1.f / DM) + LN_EPS);
        u32x2* xb = WSP(u32x2, WS_XB) + (size_t)tok * (DM / 4) + C.lane;
#pragma unroll
        for (int j = 0; j < 4; ++j) { v[j] = v[j] * rstd * gv[j] + bv[j]; xr[64 * j] = v[j];
            u32x2 w; w.x = cvt_pk_bf16(v[j][0], v[j][1]); w.y = cvt_pk_bf16(v[j][2], v[j][3]); xb[64 * j] = w;
            if (out) ((f32x4*)(out + (size_t)tok * DM) + C.lane)[64 * j] = v[j]; }
        if (do_gate) fox_gate_row(v, fgT, fox_b_f, WSP(float, WS_MISC + MS_LOGF), tok, C.lane);
    }
}

__device__ __forceinline__ void phase_kmean(const Ctx& C) {
    LAS float* red = (LAS float*)C.lds;
    const bf16_t* K = WSP(bf16_t, WS_K); float* KM = WSP(float, WS_MISC + MS_KMEAN);
    for (int u = C.vcu; u < 512; u += C.G) {
        const int bh = u >> 4, n = u & 15, b = bh >> 3, h = bh & 7; const int cg = C.tid & 15, rp = C.tid >> 4;
        float a[8] = {0.f, 0.f, 0.f, 0.f, 0.f, 0.f, 0.f, 0.f};
#pragma unroll
        for (int i = 0; i < 8; ++i) { const u32x4 w = *(const u32x4*)(K + ((size_t)b * SEQ + n * 256 + rp + 32 * i) * 1024 + h * 128 + cg * 8);
            a[0] += bflo(w.x); a[1] += bfhi(w.x); a[2] += bflo(w.y); a[3] += bfhi(w.y); a[4] += bflo(w.z); a[5] += bfhi(w.z); a[6] += bflo(w.w); a[7] += bfhi(w.w); }
#pragma unroll
        for (int i = 0; i < 8; ++i) red[rp * 128 + cg * 8 + i] = a[i];
        LDS_WAIT(); __syncthreads();
        if (C.tid < 128) { float s = 0.f;
#pragma unroll
            for (int r = 0; r < 32; ++r) s += red[r * 128 + C.tid];
            KM[(size_t)u * 128 + C.tid] = s * (1.0f / 256.0f); }
        LDS_WAIT(); __syncthreads();
    }
}

__device__ __forceinline__ void phase_ret_kT(const Ctx& C) {
    LAS unsigned short* tl = (LAS unsigned short*)(C.lds + C.wave * 8448);
    const bf16_t* Kp = WSP(bf16_t, WS_K); bf16_t* KT = WSP(bf16_t, WS_KT);
    const int gw = C.vcu * NWAVES + C.wave, NGW = C.G * NWAVES, ch = C.lane & 7, rr = C.lane >> 3;
    for (int it = gw; it < 256 * 16; it += NGW) {
        const int tt = it >> 4, ct = it & 15, tok0 = tt * 64, col0 = ct * 64, b = tok0 >> 12, s0 = tok0 & 4095;
#pragma unroll
        for (int p = 0; p < 8; ++p) { const int row = p * 8 + rr; const u32x4 w = *(const u32x4*)(Kp + (size_t)(tok0 + row) * 1024 + col0 + ch * 8);
            LAS unsigned short* d = tl + row * 66 + ch * 8;
            d[0] = (unsigned short)w.x; d[1] = (unsigned short)(w.x >> 16); d[2] = (unsigned short)w.y; d[3] = (unsigned short)(w.y >> 16);
            d[4] = (unsigned short)w.z; d[5] = (unsigned short)(w.z >> 16); d[6] = (unsigned short)w.w; d[7] = (unsigned short)(w.w >> 16); }
        LDS_WAIT(); asm volatile("" ::: "memory");
#pragma unroll
        for (int p = 0; p < 8; ++p) { const int c = p * 8 + rr; const LAS unsigned short* sp = tl + (ch * 8) * 66 + c;
            u32x4 w; w.x = (unsigned)sp[0] | ((unsigned)sp[66] << 16); w.y = (unsigned)sp[2 * 66] | ((unsigned)sp[3 * 66] << 16);
            w.z = (unsigned)sp[4 * 66] | ((unsigned)sp[5 * 66] << 16); w.w = (unsigned)sp[6 * 66] | ((unsigned)sp[7 * 66] << 16);
            *(u32x4*)(KT + ((size_t)b * 1024 + col0 + c) * 4096 + s0 + ch * 8) = w; }
        LDS_WAIT(); asm volatile("" ::: "memory");
    }
}

__device__ __forceinline__ void phase_ret_scan(const Ctx& C) {
    const float* UT = WSP(float, WS_UT); bf16_t* RT = WSP(bf16_t, WS_RT);
    for (int it = C.vcu * NTHREADS + C.tid; it < 16 * 512 * 32; it += C.G * NTHREADS) {
        const int bh = it >> 14, v = (it >> 5) & 511, d = (it & 31) * 8, h = bh & 3;
        const float G = __builtin_amdgcn_exp2f(256.0f * gamma_log2(h));
        f32x4 r0 = {0.f, 0.f, 0.f, 0.f}, r1 = {0.f, 0.f, 0.f, 0.f};
#pragma unroll 4
        for (int c = 0; c < 16; ++c) {
            u32x4 w; w.x = cvt_pk_bf16(r0[0], r0[1]); w.y = cvt_pk_bf16(r0[2], r0[3]); w.z = cvt_pk_bf16(r1[0], r1[1]); w.w = cvt_pk_bf16(r1[2], r1[3]);
            *(u32x4*)(RT + ((size_t)bh * 512 + v) * 4096 + c * 256 + d) = w;
            if (c < 15) { const float* up = UT + (((size_t)bh * 16 + c) * 512 + v) * 256 + d; const f32x4 u0 = *(const f32x4*)up, u1 = *(const f32x4*)(up + 4);
                r0 = (r0 + u0) * G; r1 = (r1 + u1) * G; }
        }
    }
}

__device__ __forceinline__ void phase_ret_gn(const Ctx& C, const float* gn_g) {
    const int gw = C.vcu * NWAVES + C.wave, NGW = C.G * NWAVES;
    const float* O = WSP(float, WS_O32); const bf16_t* SG = WSP(bf16_t, WS_SG); bf16_t* Y = WSP(bf16_t, WS_Y);
    for (int tok = gw; tok < T; tok += NGW) {
#pragma unroll
        for (int h = 0; h < 4; ++h) { const size_t off = (size_t)tok * 2048 + h * 512 + C.lane * 8;
            const f32x4 a = *(const f32x4*)(O + off), b = *(const f32x4*)(O + off + 4);
            const float s = wave_sum((a[0] + a[1]) + (a[2] + a[3]) + (b[0] + b[1]) + (b[2] + b[3])); const float mu = s * (1.f / 512.f);
            const f32x4 da = a - mu, db = b - mu;
            const float q = wave_sum((da[0] * da[0] + da[1] * da[1]) + (da[2] * da[2] + da[3] * da[3]) + (db[0] * db[0] + db[1] * db[1]) + (db[2] * db[2] + db[3] * db[3]));
            const float rstd = 1.0f / sqrtf(q * (1.f / 512.f) + 1e-6f);
            const f32x4 g0 = *(const f32x4*)(gn_g + h * 512 + C.lane * 8), g1 = *(const f32x4*)(gn_g + h * 512 + C.lane * 8 + 4);
            const u32x4 sg = *(const u32x4*)(SG + off);
            const float y0 = da[0] * rstd * g0[0] * bflo(sg.x), y1 = da[1] * rstd * g0[1] * bfhi(sg.x), y2 = da[2] * rstd * g0[2] * bflo(sg.y), y3 = da[3] * rstd * g0[3] * bfhi(sg.y);
            const float y4 = db[0] * rstd * g1[0] * bflo(sg.z), y5 = db[1] * rstd * g1[1] * bfhi(sg.z), y6 = db[2] * rstd * g1[2] * bflo(sg.w), y7 = db[3] * rstd * g1[3] * bfhi(sg.w);
            u32x4 w; w.x = cvt_pk_bf16(y0, y1); w.y = cvt_pk_bf16(y2, y3); w.z = cvt_pk_bf16(y4, y5); w.w = cvt_pk_bf16(y6, y7);
            *(u32x4*)(Y + off) = w; }
    }
}

template <int MODE>
__device__ __forceinline__ void phase_attention(const Ctx& C) {
    char* lds = (char*)C.lds_g;
    const bf16_t* Qb = WSP(bf16_t, WS_Q); const bf16_t* Kb = WSP(bf16_t, WS_K); const bf16_t* Vb = WSP(bf16_t, WS_V); bf16_t* Ob = WSP(bf16_t, WS_OA);
    const int lane = C.lane, r32 = lane & 31;
#pragma nounroll
    for (int L = C.vcu; L < 256; L += C.G) {
        const int bh = L >> 3, x = L & 7, b = bh >> 3, h = bh & 7;
        const size_t hoff = (size_t)b * SEQ * 1024 + h * 128;
        if (MODE == 0) {
            float* cs = (float*)(lds + att::LDS_CS); float* wt = (float*)(lds + MISC_OFF + LM_SCAN);
            const float* lf = WSP(float, WS_MISC + MS_LOGF) + (size_t)bh * SEQ + C.tid * 8;
            const f32x4 a = *(const f32x4*)lf, bq = *(const f32x4*)(lf + 4);
            float p[8]; p[0] = a[0]; p[1] = p[0] + a[1]; p[2] = p[1] + a[2]; p[3] = p[2] + a[3]; p[4] = p[3] + bq[0]; p[5] = p[4] + bq[1]; p[6] = p[5] + bq[2]; p[7] = p[6] + bq[3];
            float run = p[7];
#pragma unroll
            for (int o = 1; o < 64; o <<= 1) { const float t = __shfl_up(run, o); if (lane >= o) run += t; }
            if (lane == 63) wt[C.wave] = run;
            LDS_WAIT(); __syncthreads();
            float off = run - p[7];
            for (int w = 0; w < C.wave; ++w) off += wt[w];
#pragma unroll
            for (int i = 0; i < 8; ++i) cs[C.tid * 8 + i] = -(off + p[i]) * (1.0f / att::SCALE);
            LDS_WAIT(); __syncthreads();
        }
#pragma nounroll
        for (int pss = 0; pss < 2; ++pss) {
            const int qbc = pss ? 15 - x : x;
            att::BlockRef cur;
            cur.Q = Qb + hoff + (size_t)qbc * 256 * 1024; cur.O = Ob + hoff + (size_t)qbc * 256 * 1024; cur.K = Kb + hoff; cur.V = Vb + hoff; cur.P0 = qbc * 256;
            const int qb = cur.P0 >> 8;
            int NT; unsigned long long list = 0ull; unsigned selbits = 0u;
            if (MODE == 0) { NT = 4 * (qb + 1); }
            else {
                LAS unsigned* sel = (LAS unsigned*)(C.lds + MISC_OFF + LM_SEL); LAS unsigned* uni = (LAS unsigned*)(C.lds + MISC_OFF + LM_UNI);
                LAS float* km = (LAS float*)(C.lds + att::LDS_CS);
                if (C.tid == 0) uni[0] = 0u;
                const float* KM = WSP(float, WS_MISC + MS_KMEAN) + (size_t)bh * 16 * 128;
                for (int i = C.tid; i < qb * 32; i += NTHREADS) *(LAS f32x4*)(km + i * 4) = *(const f32x4*)(KM + i * 4);
                LDS_WAIT(); __syncthreads();
                const int row = C.tid >> 1, half = C.tid & 1;
                unsigned bits;
                if (qb <= 3) bits = (1u << qb) - 1u;
                else {
                    float qv[64];
                    const u32x4* qp = (const u32x4*)(cur.Q + (size_t)row * 1024 + half * 64);
#pragma unroll
                    for (int i = 0; i < 8; ++i) { const u32x4 w = qp[i]; qv[8 * i + 0] = bflo(w.x); qv[8 * i + 1] = bfhi(w.x); qv[8 * i + 2] = bflo(w.y); qv[8 * i + 3] = bfhi(w.y);
                        qv[8 * i + 4] = bflo(w.z); qv[8 * i + 5] = bfhi(w.z); qv[8 * i + 6] = bflo(w.w); qv[8 * i + 7] = bfhi(w.w); }
                    float v0 = -__builtin_inff(), v1 = v0, v2 = v0; int i0 = 0, i1 = 0, i2 = 0;
                    for (int n = 0; n < qb; ++n) { const LAS float* kp = km + n * 128 + half * 64; float dsum = 0.f;
#pragma unroll
                        for (int i = 0; i < 16; ++i) { const f32x4 kk = *(const LAS f32x4*)(kp + 4 * i); dsum += qv[4 * i] * kk[0] + qv[4 * i + 1] * kk[1] + qv[4 * i + 2] * kk[2] + qv[4 * i + 3] * kk[3]; }
                        dsum += __shfl_xor(dsum, 1);
                        if (dsum > v0) { v2 = v1; i2 = i1; v1 = v0; i1 = i0; v0 = dsum; i0 = n; }
                        else if (dsum > v1) { v2 = v1; i2 = i1; v1 = dsum; i1 = n; }
                        else if (dsum > v2) { v2 = dsum; i2 = n; } }
                    bits = (1u << i0) | (1u << i1) | (1u << i2);
                }
                if (half == 0) { sel[row] = bits; }
                unsigned ub = bits;
#pragma unroll
                for (int o = 1; o < 64; o <<= 1) ub |= __shfl_xor(ub, o);
                if (lane == 0) atomicOr((unsigned*)uni, ub);
                LDS_WAIT(); __syncthreads();
                selbits = sel[C.wave * 32 + r32];
                const unsigned un = __builtin_amdgcn_readfirstlane(uni[0]);
                list = (unsigned long long)qb; int nb = 1;
                for (int n = qb - 1; n >= 0; --n) if ((un >> n) & 1u) { list |= (unsigned long long)n << (4 * nb); ++nb; }
                NT = 4 * nb;
            }
            att::attn_block<MODE>(cur, NT, list, lds, selbits);
        }
    }
}

struct Args { const float* in[17]; float* out; unsigned char* ws; int ph_lo, ph_hi; };
constexpr int N_PHASES = 34;


#undef WSP
#define WSP(T_, off) ((T_*)(P.ws + (off)))
#ifndef PROBE_PH
#define PROBE_PH (-1)
#define PROBE_N 1
#endif
#define PHASE_IF if (ph >= lo && ph < hi) for (int rep_ = 0; rep_ < ((ph == PROBE_PH) ? PROBE_N : 1); ++rep_)
#define PHASE_CTX Ctx P = C; { GAS unsigned char* w_ = (GAS unsigned char*)args.ws; asm volatile("" : "+s"(w_)); P.ws = (unsigned char*)w_; int t_ = threadIdx.x; asm volatile("" : "+v"(t_)); P.tid = t_; P.lane = t_ & 63; }
#define PHASE_END do { if (ph >= lo && ph + 1 < hi) { XcdBarrier b_ = bar; GAS unsigned* p_ = (GAS unsigned*)b_.bar; asm volatile("" : "+s"(p_)); b_.bar = (unsigned*)p_; xcd_barrier(b_); } ++ph; } while (0)
template <int li>
__device__ __forceinline__ void layer_body(const Ctx& C, const Args& args, const XcdBarrier& bar, const int lo, const int hi, int& ph) {
    const float* const* in = args.in; LAS unsigned char* ring = C.lds; const int G = C.G, bx = (int)blockIdx.x;
        const int kind = li % 3;
        if (kind != 2) {
            PHASE_IF { PHASE_CTX; const bf16_t* W = (kind == 0) ? WSP(bf16_t, WS_WFOXI) + (size_t)(li / 3) * 3072 * 1024 : WSP(bf16_t, WS_WMOBI);
                pg8::DenseOrder S; S.init(WSP(bf16_t, WS_XB), W, T, 3072, 1024, 1024, G, bx); pg8::EpiQKV E{WSP(bf16_t, WS_Q)};
                pg8::gemm_phase(ring, 1024, 1024, 1024, S, E); }
            PHASE_END;
            if (kind == 1) { PHASE_IF { PHASE_CTX; phase_kmean(P); } PHASE_END; }
            PHASE_IF { PHASE_CTX; if (kind == 0) phase_attention<0>(P); else phase_attention<1>(P); }
            PHASE_END;
            PHASE_IF { PHASE_CTX; const bf16_t* W = (kind == 0) ? WSP(bf16_t, WS_WFOXO) + (size_t)(li / 3) * 1024 * 1024 : WSP(bf16_t, WS_WMOBO);
                pg8::DenseOrder S; S.init(WSP(bf16_t, WS_OA), W, T, 1024, 1024, 1024, G, bx); pg8::EpiF32 E{WSP(float, WS_H), 1024};
                pg8::gemm_phase(ring, 1024, 1024, 1024, S, E); }
            PHASE_END;
        } else {
            PHASE_IF { PHASE_CTX;
                const float* tab = WSP(float, WS_TAB);
                { pg8::DenseOrder S; S.init(WSP(bf16_t, WS_XB), WSP(bf16_t, WS_WRETI), T, 2048, 1024, 1024, G, bx);
                  pg8::EpiRope E{WSP(bf16_t, WS_Q), WSP(bf16_t, WS_K), tab, tab + 4096 * 128}; pg8::gemm_phase(ring, 1024, 1024, 1024, S, E); }
                { pg8::DenseOrder S; S.init(WSP(bf16_t, WS_WRETI) + (size_t)2048 * 1024, WSP(bf16_t, WS_XB), 2048, T, 1024, 1024, G, bx);
                  pg8::EpiSwap E{WSP(bf16_t, WS_VT)}; pg8::gemm_phase(ring, 1024, 1024, 1024, S, E); }
                { pg8::DenseOrder S; S.init(WSP(bf16_t, WS_XB), WSP(bf16_t, WS_WRETI) + (size_t)4096 * 1024, T, 2048, 1024, 1024, G, bx);
                  pg8::EpiSilu E{WSP(bf16_t, WS_SG)}; pg8::gemm_phase(ring, 1024, 1024, 1024, S, E); }
            }
            PHASE_END;
            PHASE_IF { PHASE_CTX;
                { pg8::RetSOrder S{(const char*)WSP(bf16_t, WS_Q), (const char*)WSP(bf16_t, WS_K), G, bx}; pg8::EpiSMask E{WSP(bf16_t, WS_SP)}; pg8::gemm_phase(ring, 256, 1024, 1024, S, E); }
                phase_ret_kT(P);
            }
            PHASE_END;
            PHASE_IF { PHASE_CTX; pg8::RetUOrder S{(const char*)WSP(bf16_t, WS_VT), (const char*)WSP(bf16_t, WS_KT), G, bx}; pg8::EpiUT E{WSP(float, WS_UT)}; pg8::gemm_phase(ring, 256, 4096, 4096, S, E); }
            PHASE_END;
            PHASE_IF { PHASE_CTX; phase_ret_scan(P); }
            PHASE_END;
            PHASE_IF { PHASE_CTX; pg8::RetOOrder S{(const char*)WSP(bf16_t, WS_Q), (const char*)WSP(bf16_t, WS_SP), (const char*)WSP(bf16_t, WS_RT), (const char*)WSP(bf16_t, WS_VT), G, bx};
                pg8::EpiRetO E{WSP(float, WS_O32)}; pg8::gemm_phase(ring, 256, 1024, 4096, S, E); }
            PHASE_END;
            PHASE_IF { PHASE_CTX; phase_ret_gn(P, in[7]); }
            PHASE_END;
            PHASE_IF { PHASE_CTX; pg8::DenseOrder S; S.init(WSP(bf16_t, WS_Y), WSP(bf16_t, WS_WRETO), T, 1024, 2048, 2048, G, bx); pg8::EpiF32 E{WSP(float, WS_H), 1024};
                pg8::gemm_phase(ring, 2048, 2048, 2048, S, E); }
            PHASE_END;
        }
        PHASE_IF { PHASE_CTX; phase_ln1_router(P, li, in); }
        PHASE_END;
        for (int mm = 0; mm < 2; ++mm) {
            PHASE_IF { PHASE_CTX;
                LAS int* tstart = (LAS int*)(P.lds + MISC_OFF + LM_TSTART);
                if (P.tid < 64) { const unsigned* cnt = WSP(unsigned, WS_CTL) + CW_CNT + li * 32; int nt_ = 0; if (P.lane < 32) nt_ = ((int)__hip_atomic_load(cnt + P.lane, __ATOMIC_RELAXED, __HIP_MEMORY_SCOPE_AGENT) + 255) >> 8;
                    int inc = nt_;
#pragma unroll
                    for (int o = 1; o < 32; o <<= 1) { const int t_ = __shfl_up(inc, o); if (P.lane >= o) inc += t_; }
                    if (P.lane < 32) tstart[P.lane + 1] = inc; if (P.lane == 0) tstart[0] = 0; }
                LDS_WAIT(); __syncthreads();
                const int ntiles = tstart[32];
                if (mm == 0) { pg8::MoeOrder S{(const char*)WSP(bf16_t, WS_XS), (const char*)(WSP(bf16_t, WS_W1T) + (size_t)li * 32 * 2048 * 1024), tstart, (size_t)2048 * 1024 * 2, ntiles, 8, G, bx, 1024u};
                    pg8::EpiSwiglu E{WSP(bf16_t, WS_ACT), in[14] + (size_t)li * 32 * 2048}; pg8::gemm_phase(ring, 1024, 1024, 1024, S, E); }
                else { pg8::MoeOrder S{(const char*)WSP(bf16_t, WS_ACT), (const char*)(WSP(bf16_t, WS_W2T) + (size_t)li * 32 * 1024 * 1024), tstart, (size_t)1024 * 1024 * 2, ntiles, 4, G, bx, 1024u};
                    pg8::EpiY E{WSP(bf16_t, WS_XS), in[16] + (size_t)li * 32 * 1024}; pg8::gemm_phase(ring, 1024, 1024, 1024, S, E); }
            }
            PHASE_END;
        }
        PHASE_IF { PHASE_CTX; phase_ln2(P, li, in, li == 3 ? args.out : nullptr, li == 2, in[1] + (size_t)1 * 1024 * 3080, in[2] + 8); }
        PHASE_END;
    }
__global__ void __launch_bounds__(NTHREADS, 2) mk_fwd(Args args) {
    extern __shared__ __attribute__((aligned(16))) unsigned char lds_raw[];
    Ctx C; C.lds_g = lds_raw; C.lds = (LAS unsigned char*)lds_raw; C.ws = args.ws;
    C.tid = threadIdx.x; C.lane = C.tid & 63; C.wave = __builtin_amdgcn_readfirstlane(C.tid >> 6); C.G = gridDim.x;
    { const int bx = blockIdx.x; C.vcu = (C.G % 8 == 0) ? (bx % 8) * (C.G / 8) + bx / 8 : bx; }
    const float* const* in = args.in;
    for (int u = C.tid; u < (LDS_BYTES - MISC_OFF) / 4; u += NTHREADS) ((LAS unsigned*)(C.lds + MISC_OFF))[u] = 0u;
    __syncthreads();
    unsigned* ctl0 = (unsigned*)(args.ws + WS_CTL);
    XcdBarrier bar = xcd_barrier_post(ctl0 + CW_BAR, (volatile LAS unsigned*)(C.lds + MISC_OFF + LM_BAR));
    const int lo = args.ph_lo, hi = args.ph_hi;
    int ph = 0;
    LAS unsigned char* ring = C.lds;
    const int G = C.G, bx = (int)blockIdx.x;

    PHASE_IF { PHASE_CTX; phase_prologue(P, in); }
    PHASE_END;

    layer_body<0>(C, args, bar, lo, hi, ph);
    layer_body<1>(C, args, bar, lo, hi, ph);
    layer_body<2>(C, args, bar, lo, hi, ph);
    layer_body<3>(C, args, bar, lo, hi, ph);
}
#undef PHASE_IF
#undef PHASE_END

extern "C" void kernel_launch(void* const* d_in, const int* in_sizes, int n_in, void* d_out, int out_size, void* d_ws, size_t ws_size, hipStream_t stream) {
    static int grid = 0;
    if (grid == 0) {
        if (n_in != 17 || out_size != T * DM || ws_size < WS_END) { fprintf(stderr, "kernel_launch: unexpected shapes (n_in %d out %d ws %zu)\n", n_in, out_size, ws_size); grid = -1; return; }
        int dev = 0, cus = 0;
        if (hipGetDevice(&dev) != hipSuccess || hipDeviceGetAttribute(&cus, hipDeviceAttributeMultiprocessorCount, dev) != hipSuccess) { grid = -1; return; }
        if (hipFuncSetAttribute((const void*)mk_fwd, hipFuncAttributeMaxDynamicSharedMemorySize, LDS_BYTES) != hipSuccess) { fprintf(stderr, "kernel_launch: hipFuncSetAttribute failed\n"); grid = -1; return; }
        int per_cu = 0;
        if (hipOccupancyMaxActiveBlocksPerMultiprocessor(&per_cu, (const void*)mk_fwd, NTHREADS, LDS_BYTES) != hipSuccess || per_cu < 1) fprintf(stderr, "kernel_launch: occupancy query says %d\n", per_cu);
        (void)hipGetLastError();
        grid = cus;
    }
    if (grid < 0) return;
    (void)hipMemsetAsync((char*)d_ws + WS_CTL, 0, CTL_BYTES, stream);
    Args a{};
    for (int i = 0; i < 17; ++i) a.in[i] = (const float*)d_in[i];
    a.out = (float*)d_out; a.ws = (unsigned char*)d_ws;
#if defined(MK_PER_PHASE)
    for (int p = 0; p < N_PHASES; ++p) { a.ph_lo = p; a.ph_hi = p + 1; hipLaunchKernelGGL(mk_fwd, dim3(grid), dim3(NTHREADS), LDS_BYTES, stream, a); }
#else
    a.ph_lo = 0; a.ph_hi = N_PHASES;
    hipLaunchKernelGGL(mk_fwd, dim3(grid), dim3(NTHREADS), LDS_BYTES, stream, a);
#endif
    const hipError_t le = hipPeekAtLastError();
    if (le != hipSuccess) fprintf(stderr, "kernel_launch: launch failed: %s\n", hipGetErrorName(le));
}
```
